# Optimizing an MI355X kernel written in HIP

```python
import jax, jax.numpy as jnp
from jax import lax
import numpy as np

D_MODEL = 2048
BATCH = 8
SEQ = 2048
DEPTH = 4

HEAD_DIM = 128
DIL_GROUPS = ((128, 1), (512, 4), (2048, 16))
HEADS_PER_DIL = 4
N_DIL_HEADS = HEADS_PER_DIL * len(DIL_GROUPS)
N_FOX_HEADS = 4
N_HEADS = N_DIL_HEADS + N_FOX_HEADS
ATTN_WIDTH = N_HEADS * HEAD_DIM
BRANCH_A_WIDTH = HEADS_PER_DIL * HEAD_DIM
BRANCH_B_WIDTH = N_FOX_HEADS * HEAD_DIM
IN_COLS = 3 * ATTN_WIDTH + N_FOX_HEADS
D_FF = 4 * D_MODEL
PLE_DIM = 256
ROPE_THETA = 500000.0
ROPE_DIM = HEAD_DIM // 4
BLOCK = 128
NORM_EPS = 1e-6

kernel_name = "hybrid_dilated_fox_gated_block"


def rms_norm(x, g):
    xf = x.astype(jnp.float32)
    y = xf * lax.rsqrt(jnp.mean(xf * xf, axis=-1, keepdims=True) + NORM_EPS)
    return (y * g.astype(jnp.float32)).astype(x.dtype)


def partial_rope(x):
    S = x.shape[1]
    half = ROPE_DIM // 2
    inv = ROPE_THETA ** (-jnp.arange(half, dtype=jnp.float32) / half)
    ang = jnp.arange(S, dtype=jnp.float32)[:, None] * inv[None, :]
    cos = jnp.cos(ang)[None, :, None, :]
    sin = jnp.sin(ang)[None, :, None, :]
    xr = x[..., :ROPE_DIM].astype(jnp.float32)
    x1, x2 = xr[..., :half], xr[..., half:]
    rot = jnp.concatenate([x1 * cos - x2 * sin, x2 * cos + x1 * sin], axis=-1).astype(x.dtype)
    return jnp.concatenate([rot, x[..., ROPE_DIM:]], axis=-1)


def dilated_group_attention(q, k, v, window, dilation):
    B, S, H, Dh = q.shape
    span = window // dilation
    L = S // dilation
    nb = -(-L // BLOCK)
    Lp = nb * BLOCK

    def to_blocks(t):
        t = t.reshape(B, L, dilation, H, Dh).transpose(0, 2, 1, 3, 4)
        t = jnp.pad(t, ((0, 0), (0, 0), (0, Lp - L), (0, 0), (0, 0)))
        return t.reshape(B, dilation, nb, BLOCK, H, Dh)

    def with_prev(t):
        prev = jnp.pad(t[:, :, :-1], ((0, 0), (0, 0), (1, 0), (0, 0), (0, 0), (0, 0)))
        return jnp.concatenate([prev, t], axis=3)

    qb = to_blocks(q)
    kb = with_prev(to_blocks(k))
    vb = with_prev(to_blocks(v))
    s = jnp.einsum("brnqhd,brnkhd->brnhqk", qb, kb).astype(jnp.float32) * (Dh ** -0.5)
    qi = jnp.arange(BLOCK)[:, None]
    ki = jnp.arange(2 * BLOCK)[None, :]
    dist = BLOCK + qi - ki
    band = (dist >= 0) & (dist <= span)
    key_exists = (jnp.arange(nb) > 0)[:, None, None] | (ki >= BLOCK)[None]
    mask = (band[None] & key_exists)[:, None]
    s = jnp.where(mask, s, -jnp.inf)
    lse = jax.nn.logsumexp(s, axis=-1)
    prob = jnp.exp(s - lse[..., None]).astype(v.dtype)
    o = jnp.einsum("brnhqk,brnkhd->brnqhd", prob, vb)
    o = o.reshape(B, dilation, Lp, H, Dh)[:, :, :L].transpose(0, 2, 1, 3, 4).reshape(B, S, H, Dh)
    lse = lse.transpose(0, 1, 2, 4, 3).reshape(B, dilation, Lp, H)[:, :, :L]
    lse = lse.transpose(0, 2, 1, 3).reshape(B, S, H)
    return o, lse


def dilated_mixture(q, k, v):
    outs, lses = [], []
    for g, (window, dilation) in enumerate(DIL_GROUPS):
        sl = slice(g * HEADS_PER_DIL, (g + 1) * HEADS_PER_DIL)
        o, l = dilated_group_attention(q[:, :, sl], k[:, :, sl], v[:, :, sl], window, dilation)
        outs.append(o)
        lses.append(l)
    o = jnp.stack(outs, axis=0)
    w = jax.nn.softmax(jnp.stack(lses, axis=0), axis=0)
    return jnp.sum(w[..., None].astype(o.dtype) * o, axis=0)


def forgetting_attention(q, k, v, f_logit):
    B, S, H, Dh = q.shape
    nb = S // BLOCK
    c = jnp.cumsum(jax.nn.log_sigmoid(f_logit.astype(jnp.float32)), axis=1)
    c_keys = c.transpose(0, 2, 1)[:, :, None, :]
    qb = q.reshape(B, nb, BLOCK, H, Dh).transpose(1, 0, 2, 3, 4)
    cb = c.reshape(B, nb, BLOCK, H).transpose(1, 0, 3, 2)
    kpos = jnp.arange(S)
    scale = Dh ** -0.5

    def one_block(args):
        j, qj, cj = args
        s = jnp.einsum("bqhd,bkhd->bhqk", qj, k).astype(jnp.float32) * scale
        s = s + cj[..., None] - c_keys
        qpos = j * BLOCK + jnp.arange(BLOCK)
        s = jnp.where(kpos[None, :] <= qpos[:, None], s, -jnp.inf)
        prob = jax.nn.softmax(s, axis=-1).astype(v.dtype)
        return jnp.einsum("bhqk,bkhd->bqhd", prob, v)

    out = lax.map(one_block, (jnp.arange(nb), qb, cb))
    return out.transpose(1, 0, 2, 3, 4).reshape(B, S, H, Dh)


def hybrid_layer(h, p_i, g_mix, w_in, b_f, w_gate, b_gate, w_br_a, w_br_b, w_o,
                 g_mlp, w_up, w_down, g_ple, w_ple, w_ple_gate):
    B, S, _ = h.shape
    u = rms_norm(h, g_mix)
    z = u @ w_in
    q = z[..., :ATTN_WIDTH].reshape(B, S, N_HEADS, HEAD_DIM)
    k = z[..., ATTN_WIDTH:2 * ATTN_WIDTH].reshape(B, S, N_HEADS, HEAD_DIM)
    v = z[..., 2 * ATTN_WIDTH:3 * ATTN_WIDTH].reshape(B, S, N_HEADS, HEAD_DIM)
    f_logit = z[..., 3 * ATTN_WIDTH:] + b_f

    ya = dilated_mixture(partial_rope(q[:, :, :N_DIL_HEADS]), partial_rope(k[:, :, :N_DIL_HEADS]),
                         v[:, :, :N_DIL_HEADS])
    ya = ya.reshape(B, S, BRANCH_A_WIDTH) @ w_br_a
    yb = forgetting_attention(q[:, :, N_DIL_HEADS:], k[:, :, N_DIL_HEADS:], v[:, :, N_DIL_HEADS:], f_logit)
    yb = yb.reshape(B, S, BRANCH_B_WIDTH) @ w_br_b

    gates = jax.nn.sigmoid(u @ w_gate + b_gate)
    merged = gates[..., :D_MODEL] * ya + gates[..., D_MODEL:] * yb
    h = h + merged @ w_o

    m = rms_norm(h, g_mlp)
    h = h + jnp.square(jax.nn.relu(m @ w_up)) @ w_down

    ple_gate = jax.nn.sigmoid(rms_norm(h, g_ple) @ w_ple_gate)
    h = h + ple_gate * (p_i @ w_ple)
    return h


def setup_inputs(seed: int = 0) -> dict:
    key = jax.random.key(seed)
    ks = jax.random.split(key, 20)
    f32 = jnp.float32

    def w(k, shape, fan_in):
        return jax.random.normal(k, shape, f32) * (fan_in ** -0.5)

    def gain(k, shape):
        return 1.0 + 0.02 * jax.random.normal(k, shape, f32)

    return {
        "x": jax.random.normal(ks[0], (BATCH, SEQ, D_MODEL), f32),
        "p": jax.random.normal(ks[1], (DEPTH, BATCH, SEQ, PLE_DIM), f32),
        "g_mix": gain(ks[2], (DEPTH, D_MODEL)),
        "w_in": w(ks[3], (DEPTH, D_MODEL, IN_COLS), D_MODEL),
        "b_f": 3.0 + 0.1 * jax.random.normal(ks[4], (DEPTH, N_FOX_HEADS), f32),
        "w_gate": w(ks[5], (DEPTH, D_MODEL, 2 * D_MODEL), D_MODEL),
        "b_gate": 0.1 * jax.random.normal(ks[6], (DEPTH, 2 * D_MODEL), f32),
        "w_br_a": w(ks[7], (DEPTH, BRANCH_A_WIDTH, D_MODEL), BRANCH_A_WIDTH),
        "w_br_b": w(ks[8], (DEPTH, BRANCH_B_WIDTH, D_MODEL), BRANCH_B_WIDTH),
        "w_o": w(ks[9], (DEPTH, D_MODEL, D_MODEL), D_MODEL),
        "g_mlp": gain(ks[10], (DEPTH, D_MODEL)),
        "w_up": w(ks[11], (DEPTH, D_MODEL, D_FF), D_MODEL),
        "w_down": w(ks[12], (DEPTH, D_FF, D_MODEL), D_FF),
        "g_ple": gain(ks[13], (DEPTH, D_MODEL)),
        "w_ple": w(ks[14], (DEPTH, PLE_DIM, D_MODEL), PLE_DIM),
        "w_ple_gate": w(ks[15], (DEPTH, D_MODEL, D_MODEL), D_MODEL),
        "g_final": gain(ks[16], (D_MODEL,)),
    }


def reference(x, p, g_mix, w_in, b_f, w_gate, b_gate, w_br_a, w_br_b, w_o,
              g_mlp, w_up, w_down, g_ple, w_ple, w_ple_gate, g_final):
    h = x
    for i in range(DEPTH):
        h = hybrid_layer(h, p[i], g_mix[i], w_in[i], b_f[i], w_gate[i], b_gate[i], w_br_a[i], w_br_b[i],
                         w_o[i], g_mlp[i], w_up[i], w_down[i], g_ple[i], w_ple[i], w_ple_gate[i])
    return rms_norm(h, g_final)
```

```cpp
#define MK_SINGLE 1
#include <hip/hip_runtime.h>
#include <cstdio>
#include <cstdint>
namespace pg8 {
#define PG8_LAS __attribute__((address_space(3)))
#define PG8_GAS __attribute__((address_space(1)))
typedef unsigned short bf16_t;
typedef short bf16x8 __attribute__((ext_vector_type(8)));
typedef float f32x4 __attribute__((ext_vector_type(4)));
typedef unsigned u32x4 __attribute__((ext_vector_type(4)));
constexpr int BM = 256, BK = 64, HALF = 128, HTB = HALF * BK * 2  , STAGE_BYTES = 8 * HTB, NXCD = 8, WGM = 8;

__host__ __device__ __forceinline__ int lds_byte(int r, int c) { const int st = (r >> 4) * 2 + (c >> 5), rr = r & 15, cc = c & 31, ob = rr * 64 + cc * 2; return st * 1024 + (ob ^ (((ob >> 9) & 1) << 5)); }
__host__ __device__ __forceinline__ void stage_rc(int b, int& R, int& C) { const int st = b / 1024, sb = b % 1024, swz = sb ^ (((sb >> 9) & 1) << 5); R = (st >> 1) * 16 + swz / 64; C = (st & 1) * 32 + (swz % 64) / 2; }
__host__ __device__ __forceinline__ int perm32(int rho) { const int n = rho >> 4, i = rho & 15; return 8 * (i >> 2) + 4 * n + (i & 3); }

struct Unit { int pm, pn; };
struct Gemm { const PG8_GAS bf16_t* A; const PG8_GAS bf16_t* Bt; int M, N, K; int kdir;
};

struct StaticOrder {
    int nM, nN, nwg, G, c;
    __host__ __device__ __forceinline__ void init(int M, int N, int G_, int c_) { nM = M / BM; nN = N / BM; nwg = nM * nN; G = G_; c = c_; }
    __host__ __device__ __forceinline__ bool next(int i, Unit& u) const {
        const long L = (long)i * G + c; if (L >= nwg) return false;
        int wgid = (int)L; { const int q = nwg / NXCD, r = nwg % NXCD, xcd = wgid % NXCD, off = wgid / NXCD; wgid = (xcd < r ? xcd * (q + 1) : r * (q + 1) + (xcd - r) * q) + off; }
        const int nig = WGM * nN, gid = wgid / nig, fm = gid * WGM, gsz = (nM - fm) < WGM ? (nM - fm) : WGM;
        u.pm = fm + ((wgid % nig) % gsz); u.pn = (wgid % nig) / gsz; return true;
    }
    __device__ __forceinline__ void a_ready(const Unit&) const {}
    __device__ __forceinline__ void done(const Unit&) const {}
};

typedef __bf16 bf16x2_nat __attribute__((ext_vector_type(2)));
typedef float f32x2_nat __attribute__((ext_vector_type(2)));
__device__ __forceinline__ unsigned cvt_pk_bf16(float lo, float hi) { const f32x2_nat v = {lo, hi}; const bf16x2_nat b = __builtin_convertvector(v, bf16x2_nat); return __builtin_bit_cast(unsigned, b); }
typedef float f32x2 __attribute__((ext_vector_type(2)));
__device__ __forceinline__ int mk_lane() { unsigned m = ~0u; asm volatile("" : "+s"(m)); return (int)__builtin_amdgcn_mbcnt_hi(m, __builtin_amdgcn_mbcnt_lo(m, 0u)); }
__device__ __forceinline__ float xl_xor1(float v) { return __int_as_float(__builtin_amdgcn_update_dpp(0, __float_as_int(v), 0xB1, 0xf, 0xf, true)); }
__device__ __forceinline__ float xl_xor2(float v) { return __int_as_float(__builtin_amdgcn_update_dpp(0, __float_as_int(v), 0x4E, 0xf, 0xf, true)); }
template <int K> __device__ __forceinline__ float xl_swz(float v) { return __int_as_float(__builtin_amdgcn_ds_swizzle(__float_as_int(v), (K << 10) | 0x1f)); }
__device__ __forceinline__ float xl_sum32(float v) { auto r = __builtin_amdgcn_permlane32_swap(__float_as_uint(v), __float_as_uint(v), false, false); return __uint_as_float(r[0]) + __uint_as_float(r[1]); }
__device__ __forceinline__ float xl_other32(float v, bool low_half) { auto r = __builtin_amdgcn_permlane32_swap(__float_as_uint(v), __float_as_uint(v), false, false); return __uint_as_float(low_half ? r[1] : r[0]); }
__device__ __forceinline__ float xl_wave_sum(float v) { v += xl_xor1(v); v += xl_xor2(v); v += xl_swz<4>(v); v += xl_swz<8>(v); v += xl_swz<16>(v); return xl_sum32(v); }
__device__ __forceinline__ float bf_lo(unsigned w) { return __uint_as_float(w << 16); }
__device__ __forceinline__ float bf_hi(unsigned w) { return __uint_as_float(w & 0xffff0000u); }
__device__ __forceinline__ float h_lo(unsigned w) { return (float)__builtin_bit_cast(_Float16, (unsigned short)(w & 0xffffu)); }
__device__ __forceinline__ float h_hi(unsigned w) { return (float)__builtin_bit_cast(_Float16, (unsigned short)(w >> 16)); }
__device__ __forceinline__ float sigmoid_f(float x) { return __builtin_amdgcn_rcpf(1.0f + __builtin_amdgcn_exp2f(-1.4426950408889634f * x)); }
__device__ __forceinline__ u32x4 pack8_bf16(const f32x4& v0, const f32x4& v1) { u32x4 w; w.x = cvt_pk_bf16(v0[0], v0[1]); w.y = cvt_pk_bf16(v0[2], v0[3]); w.z = cvt_pk_bf16(v1[0], v1[1]); w.w = cvt_pk_bf16(v1[2], v1[3]); return w; }
__device__ __forceinline__ void unpack8_bf16(const u32x4& w, f32x4& a, f32x4& b) { a = (f32x4){bf_lo(w.x), bf_hi(w.x), bf_lo(w.y), bf_hi(w.y)}; b = (f32x4){bf_lo(w.z), bf_hi(w.z), bf_lo(w.w), bf_hi(w.w)}; }

struct EpiIn {
    static constexpr bool PERM = true, AFTER_DRAIN = false; static constexpr int MIDT = 0;
    PG8_GAS bf16_t* qkv; PG8_GAS bf16_t* gates; const PG8_GAS float* bgate; const PG8_GAS float* cs; const PG8_LAS float* rstd;
    __device__ __forceinline__ void operator()(const f32x4 (&acc)[2][2][4][2], const Unit& u, int wr, int wc, int fr, int fq) const {
        const int lr0 = wr * 64 + fr, cw = wc * 32 + 8 * fq;
        if (u.pn < 24) {
            const int region = u.pn >> 3, pt = u.pn & 7;
            PG8_GAS bf16_t* base = qkv + (size_t)region * ((size_t)16384 * 2048);
            const bool rope = (region < 2) && (pt < 6) && (wc == 0);
            const float sg = fq < 2 ? -1.f : 1.f;
            if (!rope) {
#pragma unroll
                for (int ai = 0; ai < 2; ++ai)
#pragma unroll
                    for (int m = 0; m < 4; ++m) {
                        const int lr = lr0 + ai * HALF + m * 16; const float rs = rstd[lr];
                        PG8_GAS bf16_t* rowp = base + ((size_t)u.pm * BM + lr) * 2048 + pt * 256 + cw;
                        *(PG8_GAS u32x4*)rowp = pack8_bf16(acc[ai][0][m][0] * rs, acc[ai][0][m][1] * rs);
                        *(PG8_GAS u32x4*)(rowp + HALF) = pack8_bf16(acc[ai][1][m][0] * rs, acc[ai][1][m][1] * rs);
                    }
            } else {
                u32x4 cw8[8][2];
#pragma unroll
                for (int g8 = 0; g8 < 8; ++g8) { const PG8_GAS u32x4* cp = (const PG8_GAS u32x4*)((const PG8_GAS unsigned*)cs + (((size_t)u.pm * BM + lr0 + (g8 >> 2) * HALF + (g8 & 3) * 16) & 2047) * 16 + (fq & 1) * 8);
                    cw8[g8][0] = cp[0]; cw8[g8][1] = cp[1]; }
#pragma unroll
                for (int g8 = 0; g8 < 8; ++g8) { const int ai = g8 >> 2, m = g8 & 3;
                    const int lr = lr0 + ai * HALF + m * 16; const size_t row = (size_t)u.pm * BM + lr; const float rs = rstd[lr];
                    PG8_GAS bf16_t* rowp = base + row * 2048 + pt * 256 + cw;
                    const u32x4 a_ = cw8[g8][0], b_ = cw8[g8][1];
                    const f32x4 c0 = {h_lo(a_.x), h_hi(a_.x), h_lo(a_.y), h_hi(a_.y)}, c1 = {h_lo(a_.z), h_hi(a_.z), h_lo(a_.w), h_hi(a_.w)};
                    const f32x4 c2 = {h_lo(b_.x), h_hi(b_.x), h_lo(b_.y), h_hi(b_.y)}, c3 = {h_lo(b_.z), h_hi(b_.z), h_lo(b_.w), h_hi(b_.w)};
#pragma unroll
                    for (int bj = 0; bj < 2; ++bj) {
                        f32x4 v0 = acc[ai][bj][m][0] * rs, v1 = acc[ai][bj][m][1] * rs, o0, o1;
#pragma unroll
                        for (int e = 0; e < 4; ++e) { o0[e] = xl_other32(v0[e], fq < 2); o1[e] = xl_other32(v1[e], fq < 2); }
                        v0 = (f32x4){v0[0] * c0[0] + sg * o0[0] * c0[1], v0[1] * c0[2] + sg * o0[1] * c0[3], v0[2] * c1[0] + sg * o0[2] * c1[1], v0[3] * c1[2] + sg * o0[3] * c1[3]};
                        v1 = (f32x4){v1[0] * c2[0] + sg * o1[0] * c2[1], v1[1] * c2[2] + sg * o1[1] * c2[3], v1[2] * c3[0] + sg * o1[2] * c3[1], v1[3] * c3[2] + sg * o1[3] * c3[3]};
                        *(PG8_GAS u32x4*)(rowp + bj * HALF) = pack8_bf16(v0, v1);
                    }
                    asm volatile("" ::: "memory");
                }
            }
        } else {
            const int gc = (u.pn - 24) * 128 + cw;
            const f32x4 bv00 = *(const PG8_GAS f32x4*)(bgate + gc), bv01 = *(const PG8_GAS f32x4*)(bgate + gc + 4), bv10 = *(const PG8_GAS f32x4*)(bgate + 2048 + gc), bv11 = *(const PG8_GAS f32x4*)(bgate + 2048 + gc + 4);
#pragma unroll
            for (int ai = 0; ai < 2; ++ai)
#pragma unroll
                for (int m = 0; m < 4; ++m) {
                    const int lr = lr0 + ai * HALF + m * 16; const size_t row = (size_t)u.pm * BM + lr; const float rs = rstd[lr];
                    PG8_GAS bf16_t* rowp = gates + row * 4096 + gc;
                    f32x4 a0 = acc[ai][0][m][0] * rs + bv00, a1 = acc[ai][0][m][1] * rs + bv01, b0 = acc[ai][1][m][0] * rs + bv10, b1 = acc[ai][1][m][1] * rs + bv11;
#pragma unroll
                    for (int e = 0; e < 4; ++e) { a0[e] = sigmoid_f(a0[e]); a1[e] = sigmoid_f(a1[e]); b0[e] = sigmoid_f(b0[e]); b1[e] = sigmoid_f(b1[e]); }
                    const u32x4 ga = pack8_bf16(a0, a1); unpack8_bf16(ga, a0, a1);
#pragma unroll
                    for (int e = 0; e < 4; ++e) { b0[e] *= __builtin_amdgcn_rcpf(a0[e]); b1[e] *= __builtin_amdgcn_rcpf(a1[e]); }
                    *(PG8_GAS u32x4*)rowp = ga;
                    *(PG8_GAS u32x4*)(rowp + 2048) = pack8_bf16(b0, b1);
                }
        }
    }
};

template <bool HAS_ADD> struct EpiGate {
    static constexpr bool PERM = true, AFTER_DRAIN = false; static constexpr int MIDT = 0;
    const PG8_GAS bf16_t* gate; const PG8_GAS bf16_t* add; PG8_GAS bf16_t* out;
    __device__ __forceinline__ void operator()(const f32x4 (&acc)[2][2][4][2], const Unit& u, int wr, int wc, int fr, int fq) const {
        const int lr0 = wr * 64 + fr, col0 = u.pn * BM + wc * 32 + 8 * fq;
#pragma unroll
        for (int ai = 0; ai < 2; ++ai) {
            u32x4 gw[4][2], aw[4][2];
#pragma unroll
            for (int m = 0; m < 4; ++m)
#pragma unroll
                for (int bj = 0; bj < 2; ++bj) { const size_t row = (size_t)u.pm * BM + lr0 + ai * HALF + m * 16; const int col = col0 + bj * HALF;
                    gw[m][bj] = *(const PG8_GAS u32x4*)(gate + row * 4096 + col);
                    if (HAS_ADD) aw[m][bj] = *(const PG8_GAS u32x4*)(add + row * 2048 + col); }
#pragma unroll
            for (int m = 0; m < 4; ++m)
#pragma unroll
                for (int bj = 0; bj < 2; ++bj) { const size_t row = (size_t)u.pm * BM + lr0 + ai * HALF + m * 16; const int col = col0 + bj * HALF;
                    f32x4 g0, g1; unpack8_bf16(gw[m][bj], g0, g1);
                    f32x4 v0 = g0 * acc[ai][bj][m][0], v1 = g1 * acc[ai][bj][m][1];
                    if (HAS_ADD) { f32x4 a0, a1; unpack8_bf16(aw[m][bj], a0, a1); v0 += a0; v1 += a1; }
                    *(PG8_GAS u32x4*)(out + row * 2048 + col) = pack8_bf16(v0, v1); }
            asm volatile("" ::: "memory");
        }
    }
};

struct EpiMerge {
    static constexpr bool PERM = true, AFTER_DRAIN = false; static constexpr int MIDT = 8;
    const PG8_GAS bf16_t* gates; PG8_GAS bf16_t* out;
    __device__ __forceinline__ void mid(f32x4 (&acc)[2][2][4][2], const Unit& u, int wr, int wc, int fr, int fq) const {
        const int lr0 = wr * 64 + fr, col0 = u.pn * BM + wc * 32 + 8 * fq;
        u32x4 r[2][4][2];
#pragma unroll
        for (int ai = 0; ai < 2; ++ai)
#pragma unroll
            for (int m = 0; m < 4; ++m)
#pragma unroll
                for (int bj = 0; bj < 2; ++bj) r[ai][m][bj] = *(const PG8_GAS u32x4*)(gates + ((size_t)u.pm * BM + lr0 + ai * HALF + m * 16) * 4096 + 2048 + col0 + bj * HALF);
#pragma unroll
        for (int ai = 0; ai < 2; ++ai)
#pragma unroll
            for (int m = 0; m < 4; ++m)
#pragma unroll
                for (int bj = 0; bj < 2; ++bj) { f32x4 r0, r1; unpack8_bf16(r[ai][m][bj], r0, r1); acc[ai][bj][m][0] *= r0; acc[ai][bj][m][1] *= r1; }
        asm volatile("" ::: "memory");
    }
    __device__ __forceinline__ void operator()(const f32x4 (&acc)[2][2][4][2], const Unit& u, int wr, int wc, int fr, int fq) const {
        const int lr0 = wr * 64 + fr, col0 = u.pn * BM + wc * 32 + 8 * fq;
#pragma unroll
        for (int ai = 0; ai < 2; ++ai) {
            u32x4 ga[4][2];
#pragma unroll
            for (int m = 0; m < 4; ++m)
#pragma unroll
                for (int bj = 0; bj < 2; ++bj) ga[m][bj] = *(const PG8_GAS u32x4*)(gates + ((size_t)u.pm * BM + lr0 + ai * HALF + m * 16) * 4096 + col0 + bj * HALF);
#pragma unroll
            for (int m = 0; m < 4; ++m)
#pragma unroll
                for (int bj = 0; bj < 2; ++bj) { f32x4 a0, a1; unpack8_bf16(ga[m][bj], a0, a1);
                    *(PG8_GAS u32x4*)(out + ((size_t)u.pm * BM + lr0 + ai * HALF + m * 16) * 2048 + col0 + bj * HALF) = pack8_bf16(a0 * acc[ai][bj][m][0], a1 * acc[ai][bj][m][1]); }
            asm volatile("" ::: "memory");
        }
    }
};

template <int MODE> struct EpiRes {
    static constexpr bool PERM = true, AFTER_DRAIN = false; static constexpr int MIDT = 0;
    const PG8_GAS bf16_t* res; PG8_GAS bf16_t* hb; PG8_GAS float* ssq; const PG8_GAS bf16_t* pp; const PG8_LAS float* rstd;
    __device__ __forceinline__ void operator()(const f32x4 (&acc)[2][2][4][2], const Unit& u, int wr, int wc, int fr, int fq) const {
        const int lr0 = wr * 64 + fr, col0 = u.pn * BM + wc * 32 + 8 * fq;
        constexpr int NB = 4;
#pragma unroll
        for (int g0 = 0; g0 < 8; g0 += NB) {
            u32x4 rw[NB][2], pw[NB][2];
#pragma unroll
            for (int gi = 0; gi < NB; ++gi)
#pragma unroll
                for (int bj = 0; bj < 2; ++bj) { const int ai = (g0 + gi) >> 2, m = (g0 + gi) & 3; const size_t o = ((size_t)u.pm * BM + lr0 + ai * HALF + m * 16) * 2048 + col0 + bj * HALF;
                    rw[gi][bj] = *(const PG8_GAS u32x4*)(res + o);
                    if (MODE == 1) pw[gi][bj] = *(const PG8_GAS u32x4*)(pp + o); }
#pragma unroll
            for (int gi = 0; gi < NB; ++gi) { const int ai = (g0 + gi) >> 2, m = (g0 + gi) & 3; const int lr = lr0 + ai * HALF + m * 16; const size_t row = (size_t)u.pm * BM + lr;
                float rs = 1.f; if (MODE == 1) rs = rstd[lr];
                float s = 0.f;
#pragma unroll
                for (int bj = 0; bj < 2; ++bj) { const size_t o = row * 2048 + col0 + bj * HALF;
                    f32x4 x0 = acc[ai][bj][m][0], x1 = acc[ai][bj][m][1];
                    if (MODE == 1) { f32x4 p0, p1; unpack8_bf16(pw[gi][bj], p0, p1);
#pragma unroll
                        for (int e = 0; e < 4; ++e) { x0[e] = sigmoid_f(x0[e] * rs) * p0[e]; x1[e] = sigmoid_f(x1[e] * rs) * p1[e]; } }
                    f32x4 r0, r1; unpack8_bf16(rw[gi][bj], r0, r1);
                    const f32x4 h0 = r0 + x0, h1 = r1 + x1;
                    *(PG8_GAS u32x4*)(hb + o) = pack8_bf16(h0, h1);
                    s += (h0[0] * h0[0] + h0[1] * h0[1]) + (h0[2] * h0[2] + h0[3] * h0[3]) + (h1[0] * h1[0] + h1[1] * h1[1]) + (h1[2] * h1[2] + h1[3] * h1[3]); }
                s += xl_swz<16>(s); s = xl_sum32(s);
                if (fq == 0) ssq[row * 32 + u.pn * 4 + wc] = s; }
            asm volatile("" ::: "memory");
        }
    }
};

template <int ACT> struct EpiOut {
    static constexpr bool PERM = true, AFTER_DRAIN = false; static constexpr int MIDT = 0;
    PG8_GAS bf16_t* out; int ldc; const PG8_LAS float* rstd;
    __device__ __forceinline__ void operator()(const f32x4 (&acc)[2][2][4][2], const Unit& u, int wr, int wc, int fr, int fq) const {
        const int lr0 = wr * 64 + fr, col0 = u.pn * BM + wc * 32 + 8 * fq;
#pragma unroll
        for (int ai = 0; ai < 2; ++ai)
#pragma unroll
            for (int m = 0; m < 4; ++m) {
                const int lr = lr0 + ai * HALF + m * 16; const size_t row = (size_t)u.pm * BM + lr;
                float rs = 1.f; if (ACT == 1) rs = rstd[lr];
                PG8_GAS bf16_t* rowp = out + row * ldc + col0;
#pragma unroll
                for (int bj = 0; bj < 2; ++bj) {
                    f32x4 v0 = acc[ai][bj][m][0], v1 = acc[ai][bj][m][1];
                    if (ACT == 1) {
#pragma unroll
                        for (int e = 0; e < 4; ++e) { const float a = fmaxf(v0[e] * rs, 0.f), b = fmaxf(v1[e] * rs, 0.f); v0[e] = a * a; v1[e] = b * b; }
                    }
                    *(PG8_GAS u32x4*)(rowp + bj * HALF) = pack8_bf16(v0, v1);
                }
            }
    }
};
template <class Epi, class Sched, bool ALIGN_EPI = false, bool SP2 = false>
__device__ __forceinline__ void gemm_phase(PG8_LAS unsigned char* lds, const Gemm g, const Sched& S, const Epi& E, const int wv  ) {
    const int lane_ = mk_lane();
    const int tid = wv * 64 + lane_, wid = wv, lane = lane_, wr = wid >> 2, wc = wid & 3, fr = lane & 15, fq = lane >> 4;
    const int K = g.K, nt = K / BK;
    unsigned voffA[2], voffB[2];
#pragma unroll
    for (int i = 0; i < 2; ++i) { int R, C; stage_rc(tid * 16 + i * 8192, R, C); const int Rb = Epi::PERM ? ((R & ~31) + perm32(R & 31)) : R;
        voffA[i] = (unsigned)(R * K + C) * 2u; voffB[i] = (unsigned)(Rb * K + C) * 2u; }
    const long kfw = (long)(BK * 2);
    const size_t hstep = (size_t)HALF * K * 2;
    const size_t tstep = 2 * hstep;
    const unsigned ldsw = (unsigned)wid * 1024u;
    const int aoff = lds_byte(wr * 64 + fr, fq * 8), boff = lds_byte(wc * 32 + fr, fq * 8);
#define PG8_SA(b, h) (((b) * 2 + (h)) * HTB)
#define PG8_SB(b, h) ((4 + (b) * 2 + (h)) * HTB)
#define PG8_STAGE(bufoff, gbase, voff) do { _Pragma("unroll") for (int _i = 0; _i < 2; ++_i) \
        __builtin_amdgcn_global_load_lds((const PG8_GAS unsigned*)((const PG8_GAS char*)(gbase) + (voff)[_i]), (PG8_LAS unsigned*)(lds + (bufoff) + ldsw + _i * 8192), 16, 0, 0); } while (0)
#define PG8_LDA(dst, b, h) do { _Pragma("unroll") for (int m = 0; m < 4; ++m) _Pragma("unroll") for (int k = 0; k < 2; ++k) dst[m][k] = *(const PG8_LAS bf16x8*)(lds + PG8_SA(b, h) + aoff + m * 2048 + k * 1024); } while (0)
#define PG8_LDB(dst, b, h) do { _Pragma("unroll") for (int n = 0; n < 2; ++n) _Pragma("unroll") for (int k = 0; k < 2; ++k) dst[n][k] = *(const PG8_LAS bf16x8*)(lds + PG8_SB(b, h) + boff + n * 2048 + k * 1024); } while (0)
#define PG8_MMA(ai, bj, At, Bt) do { __builtin_amdgcn_s_setprio(1); _Pragma("unroll") for (int m = 0; m < 4; ++m) _Pragma("unroll") for (int n = 0; n < 2; ++n) _Pragma("unroll") for (int k = 0; k < 2; ++k) \
        acc[ai][bj][m][n] = __builtin_amdgcn_mfma_f32_16x16x32_bf16(Bt[n][k], At[m][k], acc[ai][bj][m][n], 0, 0, 0); __builtin_amdgcn_s_setprio(0); } while (0)
#define PG8_WAIT_V(n) asm volatile("s_waitcnt vmcnt(" #n ")" ::: "memory")
#define PG8_WAIT_L(n) asm volatile("s_waitcnt lgkmcnt(" #n ")" ::: "memory")
#define PG8_BAR __builtin_amdgcn_s_barrier()
#define PG8_SCHED __builtin_amdgcn_sched_barrier(0)
    Unit cur, nxt; int ui = 0;
    if (!S.next(0, cur)) return;
    f32x4 acc[2][2][4][2];
#pragma unroll
    for (int a = 0; a < 2; ++a)
#pragma unroll
        for (int b = 0; b < 2; ++b)
#pragma unroll
            for (int m = 0; m < 4; ++m)
#pragma unroll
                for (int n = 0; n < 2; ++n) acc[a][b][m][n] = (f32x4){0.f, 0.f, 0.f, 0.f};
    bf16x8 At[4][2], B0[2][2], B1[2][2];
    const bool rev0 = g.kdir != 0; long kstep = rev0 ? -kfw : kfw;
    const PG8_GAS char* cA = (const PG8_GAS char*)g.A + (size_t)cur.pm * tstep + (rev0 ? (long)(nt - 1) * kfw : 0); const PG8_GAS char* cB = (const PG8_GAS char*)g.Bt + (size_t)cur.pn * tstep + (rev0 ? (long)(nt - 1) * kfw : 0);
    S.a_ready(cur);
    if constexpr (SP2) {
        PG8_STAGE(PG8_SB(0, 0), cB, voffB); PG8_STAGE(PG8_SB(0, 1), cB + hstep, voffB); PG8_STAGE(PG8_SA(0, 0), cA, voffA); PG8_STAGE(PG8_SA(0, 1), cA + hstep, voffA);
        if (wr == 1) PG8_BAR;
        PG8_WAIT_V(2); PG8_BAR;
        PG8_STAGE(PG8_SB(1, 0), cB + kstep, voffB); PG8_STAGE(PG8_SA(1, 0), cA + kstep, voffA); PG8_STAGE(PG8_SB(1, 1), cB + hstep + kstep, voffB);
        PG8_WAIT_V(6); PG8_BAR;
    } else {
        PG8_STAGE(PG8_SB(0, 0), cB, voffB); PG8_STAGE(PG8_SA(0, 0), cA, voffA); PG8_STAGE(PG8_SB(0, 1), cB + hstep, voffB); PG8_STAGE(PG8_SA(0, 1), cA + hstep, voffA);
        if (wr == 1) PG8_BAR;
        PG8_WAIT_V(4); PG8_BAR;
        PG8_STAGE(PG8_SB(1, 0), cB + kstep, voffB); PG8_STAGE(PG8_SA(1, 0), cA + kstep, voffA); PG8_STAGE(PG8_SB(1, 1), cB + hstep + kstep, voffB);
        PG8_WAIT_V(6); PG8_BAR;
    }
    for (;;) {
        const bool has_next = S.next(ui + 1, nxt);
        const bool revn = g.kdir != 0 && ((ui + 1) & 1) == 0; const long kstepn = has_next ? (revn ? -kfw : kfw) : kstep;
        const PG8_GAS char* nA = has_next ? (const PG8_GAS char*)g.A + (size_t)nxt.pm * tstep + (revn ? (long)(nt - 1) * kfw : 0) : cA; const PG8_GAS char* nB = has_next ? (const PG8_GAS char*)g.Bt + (size_t)nxt.pn * tstep + (revn ? (long)(nt - 1) * kfw : 0) : cB;
        for (int t = 0; t < nt; t += 2) {
            const bool last = (t == nt - 2);
            const PG8_GAS char* a1 = cA + (long)(t + 1) * kstep;
            const PG8_GAS char* a2 = last ? nA : cA + (long)(t + 2) * kstep; const PG8_GAS char* b2 = last ? nB : cB + (long)(t + 2) * kstep;
            const long ks3 = last ? kstepn : kstep; const PG8_GAS char* a3 = a2 + ks3; const PG8_GAS char* b3 = b2 + ks3;
            if (last && has_next) S.a_ready(nxt);
            if constexpr (SP2) {
            PG8_LDB(B0, 0, 0); PG8_LDB(B1, 0, 1); PG8_SCHED; PG8_LDA(At, 0, 0); PG8_STAGE(PG8_SA(1, 1), a1 + hstep, voffA);
            PG8_WAIT_V(8); PG8_WAIT_L(0); PG8_BAR; PG8_MMA(0, 0, At, B0); PG8_MMA(0, 1, At, B1); PG8_BAR; PG8_SCHED;
            PG8_LDA(At, 0, 1); PG8_STAGE(PG8_SB(0, 0), b2, voffB); PG8_STAGE(PG8_SB(0, 1), b2 + hstep, voffB); PG8_STAGE(PG8_SA(0, 0), a2, voffA);
            PG8_WAIT_V(8); PG8_WAIT_L(0); PG8_BAR; PG8_MMA(1, 0, At, B0); PG8_MMA(1, 1, At, B1); PG8_BAR; PG8_SCHED;
            PG8_LDB(B0, 1, 0); PG8_LDB(B1, 1, 1); PG8_SCHED; PG8_LDA(At, 1, 0); PG8_STAGE(PG8_SA(0, 1), a2 + hstep, voffA);
            PG8_WAIT_V(8); PG8_WAIT_L(0); PG8_BAR; PG8_MMA(0, 0, At, B0); PG8_MMA(0, 1, At, B1); PG8_BAR; PG8_SCHED;
            PG8_LDA(At, 1, 1); PG8_STAGE(PG8_SB(1, 0), b3, voffB); PG8_STAGE(PG8_SB(1, 1), b3 + hstep, voffB); PG8_STAGE(PG8_SA(1, 0), a3, voffA);
            PG8_WAIT_V(8); PG8_WAIT_L(0); PG8_BAR; PG8_MMA(1, 0, At, B0); PG8_MMA(1, 1, At, B1); PG8_BAR; PG8_SCHED;
            } else {
            PG8_LDB(B0, 0, 0); PG8_SCHED; PG8_LDA(At, 0, 0); PG8_STAGE(PG8_SA(1, 1), a1 + hstep, voffA);
            PG8_WAIT_L(8); PG8_BAR; PG8_WAIT_L(0); PG8_MMA(0, 0, At, B0); PG8_BAR; PG8_SCHED;
            PG8_LDB(B1, 0, 1); PG8_STAGE(PG8_SB(0, 0), b2, voffB);
            PG8_BAR; PG8_WAIT_L(0); PG8_MMA(0, 1, At, B1); PG8_BAR;
            PG8_LDA(At, 0, 1); PG8_STAGE(PG8_SA(0, 0), a2, voffA);
            PG8_BAR; PG8_WAIT_L(0); PG8_MMA(1, 0, At, B0); PG8_BAR; PG8_SCHED;
            PG8_STAGE(PG8_SB(0, 1), b2 + hstep, voffB);
            PG8_WAIT_V(6); PG8_BAR; PG8_MMA(1, 1, At, B1); PG8_BAR;
            PG8_LDB(B0, 1, 0); PG8_SCHED; PG8_LDA(At, 1, 0); PG8_STAGE(PG8_SA(0, 1), a2 + hstep, voffA);
            PG8_WAIT_L(8); PG8_BAR; PG8_WAIT_L(0); PG8_MMA(0, 0, At, B0); PG8_BAR; PG8_SCHED;
            PG8_LDB(B1, 1, 1); PG8_STAGE(PG8_SB(1, 0), b3, voffB);
            PG8_BAR; PG8_WAIT_L(0); PG8_MMA(0, 1, At, B1); PG8_BAR;
            PG8_LDA(At, 1, 1); PG8_STAGE(PG8_SA(1, 0), a3, voffA);
            PG8_BAR; PG8_WAIT_L(0); PG8_MMA(1, 0, At, B0); PG8_BAR; PG8_SCHED;
            PG8_STAGE(PG8_SB(1, 1), b3 + hstep, voffB);
            PG8_WAIT_V(6); PG8_BAR; PG8_MMA(1, 1, At, B1); PG8_BAR;
            }
            if constexpr (Epi::MIDT > 0) { if (t + 2 == Epi::MIDT) { int lm_ = lane; asm volatile("" : "+v"(lm_)); E.mid(acc, cur, wr, wc, lm_ & 15, lm_ >> 4); } }
        }
        if constexpr (ALIGN_EPI) { if (wr == 0) PG8_BAR; }
        if constexpr (!Epi::AFTER_DRAIN) { int lz_ = lane; asm volatile("" : "+v"(lz_));
            E(acc, cur, wr, wc, lz_ & 15, lz_ >> 4); S.done(cur); }
        if (!has_next) break;
#pragma unroll
        for (int a = 0; a < 2; ++a)
#pragma unroll
            for (int b = 0; b < 2; ++b)
#pragma unroll
                for (int m = 0; m < 4; ++m)
#pragma unroll
                    for (int n = 0; n < 2; ++n) acc[a][b][m][n] = (f32x4){0.f, 0.f, 0.f, 0.f};
        cur = nxt; cA = nA; cB = nB; kstep = kstepn; ++ui;
        if constexpr (ALIGN_EPI) { if (wr == 1) PG8_BAR; }
    }
    PG8_WAIT_V(0);
    if constexpr (!ALIGN_EPI) { if (wr == 0) PG8_BAR; }
    PG8_BAR;
    if constexpr (Epi::AFTER_DRAIN) { E.fused(acc, cur, wr, wc, fr, fq, lds, wid, lane); S.done(cur); }
#undef PG8_SA
#undef PG8_SB
#undef PG8_STAGE
#undef PG8_LDA
#undef PG8_LDB
#undef PG8_MMA
#undef PG8_WAIT_V
#undef PG8_WAIT_L
#undef PG8_BAR
#undef PG8_SCHED
}
}
namespace att {
typedef unsigned short bf16;
typedef short bf16x8 __attribute__((ext_vector_type(8)));
typedef short s16x4 __attribute__((ext_vector_type(4)));
typedef float f32x16 __attribute__((ext_vector_type(16)));
typedef float f32x4 __attribute__((ext_vector_type(4)));
typedef unsigned u32x4 __attribute__((ext_vector_type(4)));
#define ATT_LAS __attribute__((address_space(3)))
#define ATT_GAS __attribute__((address_space(1)))
constexpr float SCALE = 0.08838834764831845f;
constexpr float THR = 8.f;
constexpr int NW = 8, QBLK = 32, KVBLK = 64, QB = NW * QBLK, DH = 128;
constexpr int SHM_V = KVBLK * DH * 2, SHM_K = KVBLK * DH * 2;
constexpr int RS = 2048, ROS = 512, SEQ = 2048;
constexpr int OFF_WS = 2 * SHM_V + 2 * SHM_K, OFF_CB = OFF_WS + NW * 64 * 4, OFF_SC = OFF_CB + SEQ * 4, ATT_LDS = OFF_SC + 64;

#define KSWZ(row, colB) ((row) * 256 + ((colB) ^ (((row) & 7) << 4)))
#define SBAR() __builtin_amdgcn_sched_barrier(0)
__device__ __forceinline__ int v_st(int k, int c) { const int kk = (k & ~0xC) | ((k & 4) << 1) | ((k & 8) >> 1); return ((kk >> 3) * 4 + (c >> 5)) * 512 + ((kk & 7) * 32 + (c & 31)) * 2; }
__device__ __forceinline__ int v_rd_base(int lane) { return ((lane & 3) << 3) | (((lane >> 2) & 3) << 6) | (((lane >> 4) & 1) << 5) | (((lane >> 5) & 1) << 8); }
constexpr int v_rd_off(int d0, int ks, int half) { return d0 * 512 + ks * 4096 + half * 2048; }
__device__ __forceinline__ int crow(int r, int hi) { return (r & 3) + 8 * (r >> 2) + 4 * hi; }
__device__ __forceinline__ unsigned cvtpk(float lo, float hi) { return pg8::cvt_pk_bf16(lo, hi); }
__device__ __forceinline__ bf16x8 load8(const ATT_GAS bf16* p) { return *(const ATT_GAS bf16x8*)p; }
__device__ __forceinline__ int tok(int v, int dlog) { const int L = SEQ >> dlog; return ((v & (L - 1)) << dlog) | (v >> (11 - dlog)); }

__device__ __forceinline__ void mask_tile(f32x16& p0, f32x16& p1, int dq, unsigned W) {
    const float NEG = -__builtin_inff();
#pragma unroll
    for (int r = 0; r < 16; ++r) {
        const int c = (r & 3) + 8 * (r >> 2);
        if ((unsigned)(dq - c) >= W) p0[r] = NEG;
        if ((unsigned)(dq - c - 32) >= W) p1[r] = NEG;
    }
}
__device__ __forceinline__ void partialSM(f32x16& p0, f32x16& p1, float& m_reg, float& mn, float& alpha) {
    float pmax = p0[0]; for (int r = 1; r < 16; ++r) pmax = fmaxf(pmax, p0[r]); for (int r = 0; r < 16; ++r) pmax = fmaxf(pmax, p1[r]);
    { auto rr = __builtin_amdgcn_permlane32_swap(__float_as_uint(pmax), __float_as_uint(pmax), false, false);
      pmax = fmaxf(__uint_as_float(rr[0]), __uint_as_float(rr[1])); }
    constexpr float C2 = 1.4426950408889634f * SCALE;
    if (__builtin_expect(__all((pmax - m_reg) * SCALE <= THR), 1)) { mn = m_reg; alpha = 1.f; }
    else { mn = fmaxf(m_reg, pmax); alpha = __builtin_amdgcn_exp2f((m_reg - mn) * C2); m_reg = mn; }
    const float mnL = -mn * C2;
    for (int r = 0; r < 16; ++r) p0[r] = fmaf(p0[r], C2, mnL); for (int r = 0; r < 16; ++r) p1[r] = fmaf(p1[r], C2, mnL);
    for (int r = 0; r < 16; ++r) p0[r] = __builtin_amdgcn_exp2f(p0[r]);
}
__device__ __forceinline__ void finishSM(f32x16& p0, f32x16& p1, float alpha, float& l_reg, bf16x8& pa0, bf16x8& pa1, bf16x8& pa2, bf16x8& pa3) {
    for (int r = 0; r < 16; ++r) p1[r] = __builtin_amdgcn_exp2f(p1[r]);
    float ps = 0; for (int r = 0; r < 16; ++r) ps += p0[r]; for (int r = 0; r < 16; ++r) ps += p1[r];
    { auto rr = __builtin_amdgcn_permlane32_swap(__float_as_uint(ps), __float_as_uint(ps), false, false);
      ps = __uint_as_float(rr[0]) + __uint_as_float(rr[1]); }
    l_reg = l_reg * alpha + ps;
#define PK4(P, B_, OUT) do { unsigned a0 = cvtpk(P[B_+0], P[B_+1]), a1 = cvtpk(P[B_+2], P[B_+3]);                          \
        unsigned b0 = cvtpk(P[B_+4], P[B_+5]), b1 = cvtpk(P[B_+6], P[B_+7]);                                             \
        auto r0 = __builtin_amdgcn_permlane32_swap(a0, b0, false, false); auto r1 = __builtin_amdgcn_permlane32_swap(a1, b1, false, false); \
        u32x4 w = {r0[0], r1[0], r0[1], r1[1]}; OUT = *reinterpret_cast<bf16x8*>(&w); } while (0)
    PK4(p0, 0, pa0); PK4(p0, 8, pa1); PK4(p1, 0, pa2); PK4(p1, 8, pa3);
#undef PK4
}
template <int KB, bool SK, bool BIAS>
__device__ __forceinline__ void qkt(f32x16& p0, f32x16& p1, const ATT_LAS char* K_lds, int r32, int hi, const bf16x8* qr, bool act, const ATT_LAS float* cbt) {
    if (SK && !act) { const float NEG = -__builtin_inff();
#pragma unroll
        for (int r = 0; r < 16; ++r) { p0[r] = NEG; p1[r] = NEG; } return; }
    if (BIAS) {
#pragma unroll
        for (int g = 0; g < 4; ++g) { const f32x4 a = *(const ATT_LAS f32x4*)(cbt + 8 * g + 4 * hi), b = *(const ATT_LAS f32x4*)(cbt + 32 + 8 * g + 4 * hi);
            p0[4 * g] = a[0]; p0[4 * g + 1] = a[1]; p0[4 * g + 2] = a[2]; p0[4 * g + 3] = a[3]; p1[4 * g] = b[0]; p1[4 * g + 1] = b[1]; p1[4 * g + 2] = b[2]; p1[4 * g + 3] = b[3]; }
    } else { p0 = f32x16{}; p1 = f32x16{}; }
    const ATT_LAS char* kb[4];
#pragma unroll
    for (int dd = 0; dd < 4; ++dd) kb[dd] = K_lds + KB * SHM_K + KSWZ(r32, (dd * 16 + hi * 8) * 2);
#pragma unroll
    for (int d0 = 0; d0 < 8; ++d0) { const ATT_LAS char* a = kb[d0 & 3] + (d0 >> 2) * 128;
        bf16x8 b0 = *(const ATT_LAS bf16x8*)a;
        bf16x8 b1 = *(const ATT_LAS bf16x8*)(a + 32 * 256);
        p0 = __builtin_amdgcn_mfma_f32_32x32x16_bf16(b0, qr[d0], p0, 0, 0, 0);
        p1 = __builtin_amdgcn_mfma_f32_32x32x16_bf16(b1, qr[d0], p1, 0, 0, 0); }
}
template <int VB, bool SK>
__device__ __forceinline__ void pv_tile(f32x16* o, int vb0, bf16x8 pa0, bf16x8 pa1, bf16x8 pa2, bf16x8 pa3, bool act) {
    if (SK && !act) return;
#define TRRD(dst, off) asm volatile("ds_read_b64_tr_b16 %0, %1 offset:%2" : "=&v"(dst) : "v"(vb0), "i"(off) : "memory")
#define PV_D0(d0) do { s16x4 l0, l1, l2, l3, h0, h1, h2, h3; constexpr int b_ = VB * SHM_V + v_rd_off(d0, 0, 0); \
        TRRD(l0, b_); TRRD(h0, b_ + 2048); TRRD(l1, b_ + 4096); TRRD(h1, b_ + 6144); TRRD(l2, b_ + 8192); TRRD(h2, b_ + 10240); TRRD(l3, b_ + 12288); TRRD(h3, b_ + 14336); \
        asm volatile("s_waitcnt lgkmcnt(0)" ::: "memory"); SBAR();   \
        o[d0] = __builtin_amdgcn_mfma_f32_32x32x16_bf16(pa0, (bf16x8){l0[0], l0[1], l0[2], l0[3], h0[0], h0[1], h0[2], h0[3]}, o[d0], 0, 0, 0);   \
        o[d0] = __builtin_amdgcn_mfma_f32_32x32x16_bf16(pa1, (bf16x8){l1[0], l1[1], l1[2], l1[3], h1[0], h1[1], h1[2], h1[3]}, o[d0], 0, 0, 0);   \
        o[d0] = __builtin_amdgcn_mfma_f32_32x32x16_bf16(pa2, (bf16x8){l2[0], l2[1], l2[2], l2[3], h2[0], h2[1], h2[2], h2[3]}, o[d0], 0, 0, 0);   \
        o[d0] = __builtin_amdgcn_mfma_f32_32x32x16_bf16(pa3, (bf16x8){l3[0], l3[1], l3[2], l3[3], h3[0], h3[1], h3[2], h3[3]}, o[d0], 0, 0, 0); } while (0)
    PV_D0(0); PV_D0(1); PV_D0(2); PV_D0(3);
#undef PV_D0
#undef TRRD
}

struct Bases { const ATT_GAS bf16* Q; const ATT_GAS bf16* K; const ATT_GAS bf16* V; };
struct Ref { int bo; int P0; int dlog; int du; };
struct Seam { bf16x8 qr[8]; bf16x8 st_v0, st_v1, st_k0, st_k1; };
template <bool FOX> __device__ __forceinline__ int blk_jlo(const Ref& r) {
    if (FOX) return 0;
    const int L = SEQ >> r.dlog; int lowk = r.P0 - 128; const int cs = r.P0 & ~(L - 1); if (lowk < cs) lowk = cs; return lowk / KVBLK;
}
#define AROW(p, v, dl) ((p) + (size_t)tok((v), (dl)) * RS + sc)
#define VMW() asm volatile("s_waitcnt vmcnt(0)" ::: "memory")
#define VMWN(n) asm volatile("s_waitcnt vmcnt(%0)" :: "i"(n) : "memory")
#define SLOAD_H(Kp, Vp, k0, dl) do { S.st_v0 = load8(AROW(Vp, (k0) + sr, dl)); S.st_v1 = load8(AROW(Vp, (k0) + 32 + sr, dl));              \
                         S.st_k0 = load8(AROW(Kp, (k0) + sr, dl)); S.st_k1 = load8(AROW(Kp, (k0) + 32 + sr, dl)); } while (0)
#define SWRITE_HK(bf) do { *(ATT_LAS bf16x8*)(K_lds + (bf) * SHM_K + kws) = S.st_k0; *(ATT_LAS bf16x8*)(K_lds + (bf) * SHM_K + kws + 32 * 256) = S.st_k1; } while (0)
#define SWRITE_HV(bf) do { *(ATT_LAS bf16x8*)(V_lds + (bf) * SHM_V + vst0) = S.st_v0; *(ATT_LAS bf16x8*)(V_lds + (bf) * SHM_V + vst1) = S.st_v1; } while (0)
#define SWRITE_H(bf) do { SWRITE_HV(bf); SWRITE_HK(bf); } while (0)
template <bool FOX>
__device__ __forceinline__ void blk_prime(const Bases& AB, const Ref& cur, ATT_LAS char* lds, Seam& S, const int wv) {
    const int lane_ = pg8::mk_lane();
    const int tid = wv * 64 + lane_, wid = wv, lane = lane_, r32 = lane & 31, hi = lane >> 5;
    const int sr = tid >> 4, sc = (tid & 15) * 8, kws = KSWZ(sr, sc * 2); ATT_LAS char* K_lds = lds + 2 * SHM_V;
    const int kb0 = blk_jlo<FOX>(cur) * KVBLK;
    { const ATT_GAS bf16* qp = AB.Q + cur.bo + (size_t)tok(cur.P0 + wid * QBLK + r32, cur.dlog) * RS + hi * 8;
#pragma unroll
      for (int d0 = 0; d0 < 8; ++d0) S.qr[d0] = load8(qp + d0 * 16); }
    SLOAD_H(AB.K + cur.bo, AB.V + cur.bo, kb0, cur.dlog); VMW(); SWRITE_HK(0);
    __syncthreads();
}
template <bool FOX>
__device__ __forceinline__ void blk_run(const Bases& AB, const Ref& cur, const Ref& nxt, ATT_GAS bf16* Oo, const int ros  , ATT_GAS float* LSEo, ATT_LAS char* lds, Seam& S, const int wv) {
    constexpr bool SK = !FOX, BIAS = FOX;
    const int lane_ = pg8::mk_lane();
    const int tid = wv * 64 + lane_, wid = wv, lane = lane_, r32 = lane & 31, hi = lane >> 5;
    const int j_lo = blk_jlo<FOX>(cur);
    const int j_hi = (cur.P0 + QB - 1) / KVBLK + 1;
    const int NT = j_hi - j_lo;
    const int kbn = blk_jlo<FOX>(nxt) * KVBLK;
    const int qlo = cur.P0 + wid * QBLK, qm = qlo + r32 - 4 * hi;
    const int Lm1 = (SEQ >> cur.dlog) - 1;
    int lowq = qlo - 128; { const int cs = qlo & ~Lm1; if (lowq < cs) lowq = cs; }
    unsigned Wl = 0x7fffffffu; if (!FOX) { const unsigned w1 = (unsigned)((qlo + r32) & Lm1) + 1u; Wl = w1 < 129u ? w1 : 129u; }
    ATT_LAS char* V_lds = lds; ATT_LAS char* K_lds = lds + 2 * SHM_V;
    ATT_LAS float* ws = (ATT_LAS float*)(lds + OFF_WS) + wid * 64; ATT_LAS float* li_l = ws; ATT_LAS float* al_l = ws + 32;
    const ATT_LAS float* cb = (const ATT_LAS float*)(lds + OFF_CB);
    float m_reg = -1e30f, l_reg = 0; f32x16 o[4] = {};
    const int sr = tid >> 4, sc = (tid & 15) * 8, vst0 = v_st(sr, sc), vst1 = v_st(32 + sr, sc), kws = KSWZ(sr, sc * 2);
    const int vb0 = (int)(uintptr_t)V_lds + v_rd_base(lane);
    const ATT_GAS bf16* Kh = AB.K + cur.bo; const ATT_GAS bf16* Vh = AB.V + cur.bo; const int dl = cur.dlog;
#define RESC(a) do { if (__any((a) < 1.f)) { if (hi == 0) al_l[r32] = (a); asm volatile("s_waitcnt lgkmcnt(0)" ::: "memory");              \
                     for (int d_ = 0; d_ < 4; ++d_) for (int r = 0; r < 16; ++r) o[d_][r] *= al_l[crow(r, hi)]; } } while (0)
#define KBASE(t) ((j_lo + (t)) * KVBLK)
#define ACT(t) (FOX || (KBASE(t) <= qlo + QBLK - 1 && KBASE(t) + KVBLK - 1 >= lowq))
#define MASKT(P0_, P1_, t) do { const int kb_ = KBASE(t); if (FOX) { if (kb_ + KVBLK - 1 > qlo) mask_tile(P0_, P1_, qm - kb_, Wl); } else { if (ACT(t)) mask_tile(P0_, P1_, qm - kb_, Wl); } } while (0)
#define CBT(t) (cb + KBASE(t))
    constexpr int NQL = 8;
#define SEAM_K0() do { VMWN(NQL); SWRITE_HK(0); SBAR(); } while (0)
    f32x16 pA0, pA1, pB0, pB1; float mnA, mnB, alA, alB; bf16x8 pa0, pa1, pa2, pa3;
    SWRITE_HV(0); SBAR();
    if (NT > 1) { SLOAD_H(Kh, Vh, KBASE(1), dl); }
    SBAR(); qkt<0, SK, BIAS>(pA0, pA1, K_lds, r32, hi, S.qr, ACT(0), CBT(0));
    MASKT(pA0, pA1, 0); partialSM(pA0, pA1, m_reg, mnA, alA);
    if (NT > 1) { VMW(); SWRITE_H(1); }
    __syncthreads();
#define HALF_STEP(PX0, PX1, mnX, alX, PY0, PY1, alY, t, KB, VB, SB) do {                                                      \
        SBAR(); qkt<KB, SK, BIAS>(PX0, PX1, K_lds, r32, hi, S.qr, ACT(t), CBT(t));                                             \
        finishSM(PY0, PY1, alY, l_reg, pa0, pa1, pa2, pa3); SBAR();                                                           \
        if ((t) + 1 < NT) { SLOAD_H(Kh, Vh, KBASE((t) + 1), dl); SBAR(); }                                               \
        pv_tile<VB, SK>(o, vb0, pa0, pa1, pa2, pa3, ACT((t) - 1)); MASKT(PX0, PX1, (t)); partialSM(PX0, PX1, m_reg, mnX, alX);                                        \
        __syncthreads();                                                                                                      \
        if ((t) + 1 < NT) { VMW(); SWRITE_H(SB); }                                                                          \
        RESC(alX); __syncthreads(); } while (0)
    for (int t = 1; t + 1 < NT; t += 2) {
        HALF_STEP(pB0, pB1, mnB, alB, pA0, pA1, alA, t, 1, 0, 0);
        HALF_STEP(pA0, pA1, mnA, alA, pB0, pB1, alB, t + 1, 0, 1, 1);
    }
    const bool even = (NT & 1) == 0;
    if (even) { SBAR(); qkt<1, SK, BIAS>(pB0, pB1, K_lds, r32, hi, S.qr, ACT(NT - 1), CBT(NT - 1)); SBAR(); }
    { SLOAD_H(AB.K + nxt.bo, AB.V + nxt.bo, kbn, nxt.dlog); SBAR();
      const ATT_GAS bf16* qp = AB.Q + nxt.bo + (size_t)tok(nxt.P0 + wid * QBLK + r32, nxt.dlog) * RS + hi * 8;
#pragma unroll
      for (int d0 = 0; d0 < 8; ++d0) S.qr[d0] = load8(qp + d0 * 16); }
    SBAR();
    finishSM(pA0, pA1, alA, l_reg, pa0, pa1, pa2, pa3); SBAR();
    pv_tile<0, SK>(o, vb0, pa0, pa1, pa2, pa3, ACT(even ? NT - 2 : NT - 1));
    if (even) { MASKT(pB0, pB1, NT - 1); partialSM(pB0, pB1, m_reg, mnB, alB); __syncthreads(); RESC(alB);
        finishSM(pB0, pB1, alB, l_reg, pa0, pa1, pa2, pa3); SBAR(); pv_tile<1, SK>(o, vb0, pa0, pa1, pa2, pa3, ACT(NT - 1)); }
    SBAR(); SEAM_K0();
    if (hi == 0) li_l[r32] = l_reg; asm volatile("s_waitcnt lgkmcnt(0)" ::: "memory");
    float rli[16];
#pragma unroll
    for (int r = 0; r < 16; ++r) rli[r] = __builtin_amdgcn_rcpf(li_l[crow(r, hi)]);
#pragma unroll
    for (int r = 0; r < 16; ++r) { const int orow = crow(r, hi);
        ATT_GAS bf16* Ow = Oo + (size_t)tok(qlo + orow, dl) * ros + r32;
#pragma unroll
        for (int d0 = 0; d0 < 4; ++d0) { const float v = o[d0][r] * rli[r];
            const float vn = __int_as_float(__builtin_amdgcn_update_dpp(0, __float_as_int(v), 0xB1, 0xf, 0xf, true));
            if ((r32 & 1) == 0) *(ATT_GAS unsigned*)(Ow + d0 * 32) = cvtpk(v, vn); } }
    if (!FOX) { if (hi == 0) LSEo[(size_t)tok(qlo + r32, dl) * 4] = m_reg * SCALE + 0.6931471805599453f * __builtin_amdgcn_logf(l_reg); }
    __syncthreads();
#undef RESC
#undef KBASE
#undef ACT
#undef MASKT
#undef CBT
#undef SEAM_K0
#undef HALF_STEP
}
#undef AROW
#undef VMW
#undef VMWN
#undef SLOAD_H
#undef SWRITE_HK
#undef SWRITE_HV
#undef SWRITE_H

__device__ __forceinline__ void fox_bias(const ATT_GAS float* flog  , int kref, ATT_LAS char* lds, const int wv) {
    const int lane_ = pg8::mk_lane(); const int tid = wv * 64 + lane_, wid = wv, lane = lane_;
    ATT_LAS float* cb = (ATT_LAS float*)(lds + OFF_CB);
    ATT_LAS float* sc = (ATT_LAS float*)(lds + OFF_SC);
    float a[4];
#pragma unroll
    for (int e = 0; e < 4; ++e) { const float x = flog[(size_t)(4 * tid + e) * 4];
        a[e] = x >= 0.f ? -logf(1.0f + expf(-x)) : x - logf(1.0f + expf(x)); }
    a[1] += a[0]; a[2] += a[1]; a[3] += a[2];
    ATT_LAS float* tot = cb;
    float x = a[3]; tot[tid] = x; __syncthreads();
#pragma unroll 1
    for (int off = 1; off < 512; off <<= 1) { const float y = tid >= off ? tot[tid - off] : 0.f; __syncthreads(); x += y; tot[tid] = x; __syncthreads(); }
    const float ex = x - a[3];
    (void)sc; (void)wid; (void)lane;
#pragma unroll
    for (int e = 0; e < 4; ++e) cb[4 * tid + e] = ex + a[e];
    __syncthreads();
    const float cref = cb[kref];
    __syncthreads();
#pragma unroll
    for (int e = 0; e < 4; ++e) cb[4 * tid + e] = (cref - (ex + a[e])) * 11.313708498984761f;
    __syncthreads();
}
}
constexpr int NWAVES = 8;
#ifndef MK_SINGLE
#define MK_SINGLE 1
#endif
constexpr int BATCH = 8, SEQ = 2048, DM = 2048, DEPTH = 4, NHEAD = 16, HD = 128, DFF = 8192, PLE = 256, INC = 6148, NIN = 10240;
constexpr int M = BATCH * SEQ;
constexpr float NORM_EPS = 1e-6f;
constexpr int PH_PER_LAYER = 9, N_PHASES = 2 + DEPTH * PH_PER_LAYER;

constexpr size_t MiB = 1u << 20;
constexpr size_t WS_CTL = 0, CTL_ZERO_BYTES = 64 * 1024;
constexpr size_t WS_CS = 1 * MiB;
constexpr size_t WS_WF = 1 * MiB + 256 * 1024;
constexpr size_t WS_FLOG = 2 * MiB;
constexpr size_t WS_LSE = 3 * MiB;
constexpr size_t WS_SSQ = 4 * MiB;
constexpr size_t WS_H = 8 * MiB;
constexpr size_t WS_HB0 = 136 * MiB;
constexpr size_t WS_Q = 200 * MiB, WS_K = 264 * MiB, WS_V = 328 * MiB, WS_G = 392 * MiB;
constexpr size_t WS_MRG = WS_K, WS_UP = WS_Q;
constexpr size_t WS_PP = 736 * MiB;
constexpr size_t WS_OG = 520 * MiB, WS_YB = 568 * MiB, WS_HB1 = WS_H;
constexpr size_t WS_PB = 600 * MiB;
constexpr size_t WS_W = 608 * MiB, W_LAYER = 125 * MiB;
constexpr size_t WO_IN = 0, WO_BRB = 40 * MiB, WO_BRA = 42 * MiB, WO_O = 44 * MiB, WO_UP = 52 * MiB, WO_DOWN = 84 * MiB, WO_PG = 116 * MiB, WO_PLE = 124 * MiB;
constexpr size_t WS_W2 = WS_PP + 64 * MiB;
constexpr size_t WS_END = WS_W2 + W_LAYER;
constexpr int CW_BAR = 4096;

constexpr int RING_OFF = 0, RING_BYTES = 131072, RSTD_OFF = 131072, MISC_OFF = 135168, LDS_BYTES = 147456;
static_assert(att::ATT_LDS <= RING_BYTES, "attention LDS fits the ring region");

#define GAS __attribute__((address_space(1)))
#define LAS __attribute__((address_space(3)))
typedef unsigned short bf16;
typedef unsigned v4u __attribute__((ext_vector_type(4)));
typedef unsigned v2u __attribute__((ext_vector_type(2)));
typedef float f32x4 __attribute__((ext_vector_type(4)));
typedef GAS unsigned gu32;
#define RLX_AGENT __ATOMIC_RELAXED, __HIP_MEMORY_SCOPE_AGENT
#define LDS_WAIT() asm volatile("s_waitcnt lgkmcnt(0)" ::: "memory")
#define VM_WAIT() asm volatile("s_waitcnt vmcnt(0)" ::: "memory")
__device__ __forceinline__ unsigned f2bf(float f) { unsigned u = __builtin_bit_cast(unsigned, f); return (u + 0x7fffu + ((u >> 16) & 1u)) >> 16; }
__device__ __forceinline__ unsigned pk2(float lo, float hi) { return f2bf(lo) | (f2bf(hi) << 16); }

#define XB_TMO      128
#define XB_XCNT(j)  (256  + 64 * (j))
#define XB_XSUB(j)  (1280 + 64 * (j))
#define XB_XGEN(j)  (2304 + 64 * (j))
#define XB_TOP      3328
#define XB_TOPGEN   3392
#define XCD_BAR_WORDS 3456
#define XB_SPIN_CAP (1u << 18)
__device__ __forceinline__ unsigned xb_ld(unsigned* p)              { return __hip_atomic_load(p, __ATOMIC_RELAXED, __HIP_MEMORY_SCOPE_AGENT); }
__device__ __forceinline__ unsigned xb_add(unsigned* p, unsigned v) { return __hip_atomic_fetch_add(p, v, __ATOMIC_RELAXED, __HIP_MEMORY_SCOPE_AGENT); }
__device__ __forceinline__ unsigned xb_xcc_id() { return (unsigned)__builtin_amdgcn_s_getreg((3 << 11) | 20) & 0xFu; }
#define XB_SPIN(cond, bar) do { unsigned _sp = 0; while (cond) { __builtin_amdgcn_s_sleep(1); \
    if ((++_sp & 255u) == 0u) { if (xb_ld(&(bar)[XB_TMO])) break; if (_sp > XB_SPIN_CAP) { atomicAdd(&(bar)[XB_TMO], 1u); break; } } } } while (0)
struct XcdBarrier { unsigned* bar; unsigned x; volatile LAS unsigned* st; };
__device__ __forceinline__ XcdBarrier xcd_barrier_post(unsigned* bar, volatile LAS unsigned* st) {
    XcdBarrier b; b.bar = bar; b.x = xb_xcc_id(); b.st = st;
    if (threadIdx.x == 0) (void)xb_add(&bar[XB_XCNT(b.x)], 1u);
    return b;
}
__device__ __forceinline__ void xcd_barrier_complete(unsigned* bar, unsigned x, unsigned& nloc, unsigned& nx) {
    const unsigned G = gridDim.x * gridDim.y * gridDim.z;
    unsigned sum, cnt, mine, sp = 0u;
    for (;;) {
        sum = 0u; cnt = 0u; mine = 0u;
#pragma unroll
        for (unsigned j = 0; j < 16; ++j) { const unsigned c = xb_ld(&bar[XB_XCNT(j)]); sum += c; cnt += (c > 0u) ? 1u : 0u; mine = (j == x) ? c : mine; }
        if (sum == G) break;
        __builtin_amdgcn_s_sleep(1);
        if ((++sp & 255u) == 0u) { if (xb_ld(&bar[XB_TMO])) break; if (sp > XB_SPIN_CAP) { atomicAdd(&bar[XB_TMO], 1u); break; } }
    }
    nloc = mine > 0u ? mine : 1u; nx = cnt > 0u ? cnt : 1u;
}
__device__ __forceinline__ void xcd_barrier(const XcdBarrier& b, const bool leader  ) {
    asm volatile("s_waitcnt vmcnt(0)" ::: "memory");
    __syncthreads();
    if (leader) {
        unsigned* bar = b.bar;
        __builtin_amdgcn_s_waitcnt(0);
        unsigned nloc = b.st[0], nx = b.st[1];
        if (nloc == 0u) { xcd_barrier_complete(bar, b.x, nloc, nx); b.st[0] = nloc; b.st[1] = nx; }
        const unsigned old = xb_add(&bar[XB_XSUB(b.x)], 1u);
        const unsigned gen = old / nloc;
        if (old + 1u == (gen + 1u) * nloc) {
            __builtin_amdgcn_fence(__ATOMIC_RELEASE, "agent");
            asm volatile("s_waitcnt vmcnt(0)" ::: "memory");
            const unsigned og = xb_add(&bar[XB_TOP], 1u);
            const unsigned tg = og / nx;
            if (og + 1u == (tg + 1u) * nx) xb_add(&bar[XB_TOPGEN], 1u);
            else XB_SPIN(xb_ld(&bar[XB_TOPGEN]) == tg, bar);
            __builtin_amdgcn_fence(__ATOMIC_ACQUIRE, "agent");
            xb_add(&bar[XB_XGEN(b.x)], 1u);
            asm volatile("s_waitcnt vmcnt(0)" ::: "memory");
        } else {
            XB_SPIN(xb_ld(&bar[XB_XGEN(b.x)]) == gen, bar);
            __builtin_amdgcn_fence(__ATOMIC_ACQUIRE, "agent");
            asm volatile("s_waitcnt vmcnt(0)" ::: "memory");
        }
    }
    __syncthreads();
}

__device__ __forceinline__ int xcd_arrive(const XcdBarrier& b, unsigned& gen_out) {
    unsigned* bar = b.bar;
    __builtin_amdgcn_s_waitcnt(0);
    unsigned nloc = b.st[0], nx = b.st[1];
    if (nloc == 0u) { xcd_barrier_complete(bar, b.x, nloc, nx); b.st[0] = nloc; b.st[1] = nx; }
    const unsigned old = xb_add(&bar[XB_XSUB(b.x)], 1u);
    const unsigned gen = old / nloc; gen_out = gen;
    if (old + 1u == (gen + 1u) * nloc) {
        __builtin_amdgcn_fence(__ATOMIC_RELEASE, "agent");
        asm volatile("s_waitcnt vmcnt(0)" ::: "memory");
        const unsigned og = xb_add(&bar[XB_TOP], 1u);
        const unsigned tg = og / nx;
        if (og + 1u == (tg + 1u) * nx) xb_add(&bar[XB_TOPGEN], 1u);
        else XB_SPIN(xb_ld(&bar[XB_TOPGEN]) == tg, bar);
        __builtin_amdgcn_fence(__ATOMIC_ACQUIRE, "agent");
        xb_add(&bar[XB_XGEN(b.x)], 1u);
        asm volatile("s_waitcnt vmcnt(0)" ::: "memory");
        return 1;
    }
    return 0;
}

__device__ __forceinline__ float wave_sum(float v) { return pg8::xl_wave_sum(v); }
__device__ __forceinline__ void tr_item(const GAS float* W, int ldw, int K  , GAS bf16* WT, int row_off, const GAS float* gain, LAS float* scr, int kb, int nb, int lane, int kofs = 0) {
    const int k0 = 64 * kb, n0 = 64 * nb, c4 = 4 * (lane & 15), kq = lane >> 4;
    f32x4 w[16];
#pragma unroll
    for (int i = 0; i < 16; ++i) w[i] = __builtin_nontemporal_load((const GAS f32x4*)(W + (size_t)(k0 + 4 * i + kq) * ldw + n0 + c4));
#pragma unroll
    for (int i = 0; i < 16; ++i) { const int kk = 4 * i + kq; f32x4 v = w[i];
        if (gain) v = v * gain[k0 + kk];
        LAS float* s = scr + kk * 65 + c4; s[0] = v[0]; s[1] = v[1]; s[2] = v[2]; s[3] = v[3]; }
    LDS_WAIT(); asm volatile("" ::: "memory");
    const int c = lane & 7;
#pragma unroll
    for (int j = 0; j < 8; ++j) { const int n = (lane >> 3) + 8 * j; const LAS float* s = scr + (8 * c) * 65 + n;
        v4u o; o.x = pk2(s[0 * 65], s[1 * 65]); o.y = pk2(s[2 * 65], s[3 * 65]); o.z = pk2(s[4 * 65], s[5 * 65]); o.w = pk2(s[6 * 65], s[7 * 65]);
        __builtin_nontemporal_store(o, (GAS v4u*)(WT + (size_t)(row_off + n0 + n) * K + kofs + k0 + 8 * c)); }
    LDS_WAIT(); asm volatile("" ::: "memory");
}
__device__ __forceinline__ void rope_cs(int pos, int i, float& c, float& s) {
    const double inv = i == 0 ? 1.0 : i == 1 ? 0.44036660267178046 : i == 2 ? 0.19392274474868576 : i == 3 ? 0.08539710028576561 : i == 4 ? 0.03760603093086393 : i == 5 ? 0.016560440080994446 :
                       i == 6 ? 0.007292664737217109 : i == 7 ? 0.003211445994752591 : i == 8 ? 0.001414213562373095 : i == 9 ? 0.000622772421914596 : i == 10 ? 0.0002742481756762073 :
                       i == 11 ? 0.00012076973741146504 : i == 12 ? 5.318295896944988e-05 : i == 13 ? 2.341999896140934e-05 : i == 14 ? 1.031338537721246e-05 : 4.5416704806078695e-06;
    const double ang = (double)pos * inv;
    const double kq = rint(ang * 0.6366197723675814);
    const double r = fma(-kq, 1.5707963267948966, ang) - kq * 6.123233995736766e-17;
    const double r2 = r * r;
    double sp = r * (1.0 + r2 * (-1.0 / 6 + r2 * (1.0 / 120 + r2 * (-1.0 / 5040 + r2 * (1.0 / 362880 + r2 * (-1.0 / 39916800 + r2 * (1.0 / 6227020800.0)))))));
    double cp = 1.0 + r2 * (-0.5 + r2 * (1.0 / 24 + r2 * (-1.0 / 720 + r2 * (1.0 / 40320 + r2 * (-1.0 / 3628800 + r2 * (1.0 / 479001600 + r2 * (-1.0 / 87178291200.0)))))));
    const int q = ((int)kq) & 3;
    double cc = (q & 1) ? sp : cp, ss = (q & 1) ? cp : sp;
    if (q == 1 || q == 2) cc = -cc;
    if (q == 2 || q == 3) ss = -ss;
    c = (float)cc; s = (float)ss;
}


#define FAST_FOX 1
#define FAST_DIL 1


#define PROFARG
struct Args { const float* in[17]; float* out; unsigned char* ws; int ph_lo, ph_hi, flags, pad; };

__global__ void __launch_bounds__(NWAVES * 64, 2) mk_fwd(Args args) {
    extern __shared__ __attribute__((aligned(16))) unsigned char lds[];
    LAS unsigned char* L0 = (LAS unsigned char*)lds;
    volatile LAS unsigned* MISC0 = (volatile LAS unsigned*)(L0 + MISC_OFF);
    const int tid0 = threadIdx.x; const int wv0 = __builtin_amdgcn_readfirstlane(tid0 >> 6);
    const int G = gridDim.x, cb = blockIdx.x;
    unsigned char* ws = args.ws;
    gu32* ctl = (gu32*)(ws + WS_CTL);
    if (tid0 < 32) MISC0[tid0] = 0u;
    __syncthreads();
    if (MK_SINGLE) (void)xcd_barrier_post((unsigned*)ctl + CW_BAR, MISC0 + 8);
    const int lo = args.ph_lo, hi = args.ph_hi;
#ifndef MK_MASK
#define MK_MASK 0xfff
#endif
#define IN(k) (lo <= (k) && (k) < hi)
#define EN(b) ((MK_MASK >> (b)) & 1)
#define SEAM(k) do { if (IN((k) + 1)) { if (MK_SINGLE) { XcdBarrier b_; b_.bar = (unsigned*)(wsx + WS_CTL) + CW_BAR; b_.x = xb_xcc_id(); b_.st = MISC + 8; xcd_barrier(b_, tid == 0); } } } while (0)
    constexpr int I_IN = 32 * 96, I_G = 32 * 64, I_BR = 8 * 32, I_O = 32 * 32, I_UP = 32 * 128, I_DN = 128 * 32, I_PL = 4 * 32;
    constexpr int I_LAYER = I_IN + I_G + 2 * I_BR + I_O + I_UP + I_DN + I_O + I_PL;
#define W_ITEM(it0_, l0_, wb0_) do { int r_ = (it0_); const size_t ll_ = (size_t)(l0_); GAS unsigned char* const wd_ = (wb0_); \
        const GAS float* W_; const GAS float* gn_ = nullptr; GAS bf16* WT_; int ldw_ = DM, K_ = DM, ro_ = 0, kb_, nb_, ko_ = 0; \
        if (r_ < I_IN) { W_ = INP(3) + ll_ * DM * INC; ldw_ = INC; WT_ = (GAS bf16*)(wd_ + WO_IN); gn_ = INP(2) + ll_ * DM; kb_ = r_ / 96; nb_ = r_ % 96; } \
        else if ((r_ -= I_IN) < I_G) { kb_ = r_ / 64; nb_ = r_ % 64; W_ = INP(5) + ll_ * DM * 4096; ldw_ = 4096; WT_ = (GAS bf16*)(wd_ + WO_IN); gn_ = INP(2) + ll_ * DM; \
            ro_ = 6144 + 256 * ((nb_ & 31) >> 1) + 128 * (nb_ >> 5) + 64 * (nb_ & 1) - 64 * nb_; }     \
        else if ((r_ -= I_G) < I_BR) { W_ = INP(8) + ll_ * 512 * DM; K_ = 1024; WT_ = (GAS bf16*)(wd_ + WO_BRB); kb_ = r_ / 32; nb_ = r_ % 32; } \
        else if ((r_ -= I_BR) < I_BR) { W_ = INP(7) + ll_ * 512 * DM; K_ = 1024; WT_ = (GAS bf16*)(wd_ + WO_BRB); kb_ = r_ / 32; nb_ = r_ % 32; ko_ = 512; } \
        else if ((r_ -= I_BR) < I_O) { W_ = INP(9) + ll_ * DM * DM; WT_ = (GAS bf16*)(wd_ + WO_O); kb_ = r_ / 32; nb_ = r_ % 32; } \
        else if ((r_ -= I_O) < I_UP) { W_ = INP(11) + ll_ * DM * DFF; ldw_ = DFF; WT_ = (GAS bf16*)(wd_ + WO_UP); gn_ = INP(10) + ll_ * DM; kb_ = r_ / 128; nb_ = r_ % 128; } \
        else if ((r_ -= I_UP) < I_DN) { W_ = INP(12) + ll_ * DFF * DM; K_ = DFF; WT_ = (GAS bf16*)(wd_ + WO_DOWN); kb_ = r_ / 32; nb_ = r_ % 32; } \
        else if ((r_ -= I_DN) < I_O) { W_ = INP(15) + ll_ * DM * DM; WT_ = (GAS bf16*)(wd_ + WO_PG); gn_ = INP(13) + ll_ * DM; kb_ = r_ / 32; nb_ = r_ % 32; } \
        else { r_ -= I_O; W_ = INP(14) + ll_ * PLE * DM; K_ = PLE; WT_ = (GAS bf16*)(wd_ + WO_PLE); kb_ = r_ / 32; nb_ = r_ % 32; } \
        tr_item(W_, ldw_, K_, WT_, ro_, gn_, (LAS float*)(L + wave * (64 * 65 * 4)), kb_, nb_, lane, ko_); } while (0)
#ifndef FILL_MASK
#define FILL_MASK 0x200
#endif
#define SEAMF(k, lf_, j_) do { if (IN((k) + 1)) { if (MK_SINGLE) { XcdBarrier b_; b_.bar = (unsigned*)(wsx + WS_CTL) + CW_BAR; b_.x = xb_xcc_id(); b_.st = MISC + 8; const int lfv_ = (lf_); \
        if (lfv_ >= DEPTH || ((FILL_MASK >> (j_)) & 1) == 0) xcd_barrier(b_, tid == 0); \
        else { VM_WAIT(); __syncthreads(); \
            unsigned gen_ = 0u, pc_ = 0u; \
            if (tid == 0) MISC[12] = (unsigned)xcd_arrive(b_, gen_); \
            LDS_WAIT(); __syncthreads(); \
            GAS unsigned char* wb_ = wsx + ((lfv_ & 1) ? WS_W2 : WS_W); \
            while (__builtin_amdgcn_readfirstlane((int)MISC[12]) == 0) { \
                if (tid == 0) { bool dn_ = xb_ld(&b_.bar[XB_XGEN(b_.x)]) != gen_; \
                    if (!dn_ && (++pc_ & 255u) == 0u) { if (xb_ld(&b_.bar[XB_TMO])) dn_ = true; else if (pc_ > XB_SPIN_CAP) { atomicAdd(&b_.bar[XB_TMO], 1u); dn_ = true; } } \
                    if (dn_) { __builtin_amdgcn_fence(__ATOMIC_ACQUIRE, "agent"); VM_WAIT(); MISC[12] = 1u; LDS_WAIT(); } } \
                if (__builtin_amdgcn_readfirstlane((int)MISC[12]) != 0) break; \
                const int k_ = __builtin_amdgcn_readfirstlane((int)MISC[16 + wave]), it_ = gw + k_ * NGW;     \
                if (it_ < I_LAYER) { W_ITEM(it_, lfv_, wb_); if (lane == 0) MISC[16 + wave] = (unsigned)(k_ + 1); LDS_WAIT(); } else __builtin_amdgcn_s_sleep(8); \
            } \
            __syncthreads(); } } } } while (0)
#ifndef SHIFT_ITEMS
#define SHIFT_ITEMS 2
#endif
#define W_PART(kb_) do { if (SHIFT_ITEMS > 0 && l + 1 < DEPTH) { GAS unsigned char* wbp_ = wsx + (((l + 1) & 1) ? WS_W2 : WS_W);     \
        _Pragma("unroll 1") for (int k_ = (kb_); k_ < (kb_) + SHIFT_ITEMS; ++k_) { const int it_ = gw + k_ * NGW; if (it_ < I_LAYER) W_ITEM(it_, l + 1, wbp_); } \
        LDS_WAIT(); __syncthreads(); } } while (0)
#define W_EARLY (((cbx >> 2) & 1) != 0)

    if (tid0 < 18) { const unsigned long long pv = tid0 < 17 ? (unsigned long long)args.in[tid0] : (unsigned long long)args.out; MISC0[32 + 2 * tid0] = (unsigned)pv; MISC0[33 + 2 * tid0] = (unsigned)(pv >> 32); }
    __syncthreads();
#define INP(k) ((const GAS float*)(((unsigned long long)(unsigned)__builtin_amdgcn_readfirstlane((int)MISC[33 + 2 * (k)]) << 32) | (unsigned long long)(unsigned)__builtin_amdgcn_readfirstlane((int)MISC[32 + 2 * (k)])))
#define PHASE_BEGIN() int cbx = cb; GAS unsigned char* wsx = (GAS unsigned char*)ws; int wavep = wv0; unsigned lbp = 0u; asm volatile("" : "+s"(cbx), "+s"(wsx), "+s"(wavep), "+s"(lbp)); \
    LAS unsigned char* L = L0 + lbp; volatile LAS unsigned* MISC = (volatile LAS unsigned*)(L + MISC_OFF); const LAS float* rstd_l = (const LAS float*)(L + RSTD_OFF); \
    const int lane = pg8::mk_lane(), wave = wavep, tid = wave * 64 + lane, gw = cbx * NWAVES + wave, NGW = G * NWAVES; (void)gw; (void)NGW; (void)lane; (void)MISC; (void)rstd_l; (void)tid
#define hbuf ((GAS float*)(wsx + WS_H))
#define hb0 ((GAS bf16*)(wsx + WS_HB0))
#define hb1 ((GAS bf16*)(wsx + WS_HB1))
#define qb ((GAS bf16*)(wsx + WS_Q))
#define kbuf ((GAS bf16*)(wsx + WS_K))
#define vbuf ((GAS bf16*)(wsx + WS_V))
#define gates ((GAS bf16*)(wsx + WS_G))
#define mrg ((GAS bf16*)(wsx + WS_MRG))
#define upb ((GAS bf16*)(wsx + WS_UP))
#define ppb ((GAS bf16*)(wsx + WS_PP))
#define og ((GAS bf16*)(wsx + WS_OG))
#define y2 ((GAS bf16*)(wsx + WS_YB))
#define flog ((GAS float*)(wsx + WS_FLOG))
#define lse ((GAS float*)(wsx + WS_LSE))
#define ssq ((GAS float*)(wsx + WS_SSQ))
#define cst ((GAS float*)(wsx + WS_CS))
#define wfb ((GAS float*)(wsx + WS_WF))
#define wl (wsx + ((l & 1) ? WS_W2 : WS_W))

#define RSTD_TABLE(pm_, ssq_) do { const int r_ = tid >> 1; const GAS float* sp_ = (ssq_) + ((size_t)(pm_) * 256 + r_) * 32 + (tid & 1) * 16; \
        const f32x4 a_ = *(const GAS f32x4*)sp_, b_ = *(const GAS f32x4*)(sp_ + 4), c_ = *(const GAS f32x4*)(sp_ + 8), d_ = *(const GAS f32x4*)(sp_ + 12); \
        float s_ = ((a_[0] + a_[1]) + (a_[2] + a_[3])) + ((b_[0] + b_[1]) + (b_[2] + b_[3])) + ((c_[0] + c_[1]) + (c_[2] + c_[3])) + ((d_[0] + d_[1]) + (d_[2] + d_[3])); \
        s_ += pg8::xl_xor1(s_); if ((tid & 1) == 0) ((LAS float*)(L + RSTD_OFF))[r_] = 1.0f / sqrtf(s_ * (1.0f / DM) + NORM_EPS); LDS_WAIT(); __syncthreads(); } while (0)

    if (EN(9) && IN(0)) {
        PHASE_BEGIN();
        const int gt = cbx * (NWAVES * 64) + tid, NGT = G * NWAVES * 64;
        for (int i = gt; i < SEQ * 16; i += NGT) { float c, s; rope_cs(i >> 4, i & 15, c, s);
            ((GAS unsigned*)cst)[i] = (unsigned)__builtin_bit_cast(unsigned short, (_Float16)c) | ((unsigned)__builtin_bit_cast(unsigned short, (_Float16)s) << 16); }
#pragma unroll 2
        for (int m = gw; m < M; m += NGW) {
            const GAS f32x4* xr = (const GAS f32x4*)(INP(0) + (size_t)m * DM); float s = 0.f;
#pragma unroll
            for (int j = 0; j < 4; ++j) { const f32x4 a = xr[128 * j + 2 * lane], b = xr[128 * j + 2 * lane + 1];
                s += (a[0] * a[0] + a[1] * a[1]) + (a[2] * a[2] + a[3] * a[3]) + (b[0] * b[0] + b[1] * b[1]) + (b[2] * b[2] + b[3] * b[3]);
                v4u o; o.x = pk2(a[0], a[1]); o.y = pk2(a[2], a[3]); o.z = pk2(b[0], b[1]); o.w = pk2(b[2], b[3]);
                *(GAS v4u*)(hb1 + (size_t)m * DM + 512 * j + 8 * lane) = o; }
            s = wave_sum(s);
            if (lane < 32) ssq[(size_t)m * 32 + lane] = lane == 0 ? s : 0.f;
        }
        SEAMF(0, 0, 9);
    }

#define CONV_PWF(ll0_) do { const size_t lc_ = (size_t)(ll0_); const GAS float* gm_ = INP(2) + lc_ * DM; const int gt = cbx * (NWAVES * 64) + tid, NGT = G * NWAVES * 64; \
        for (int i = gt; i < 4 * DM; i += NGT) { const int hh = i / DM, k = i % DM; wfb[i] = gm_[k] * INP(3)[(lc_ * DM + k) * INC + 6144 + hh]; } \
        { const GAS float* p = INP(1) + lc_ * M * PLE; GAS bf16* pbf = (GAS bf16*)(wsx + WS_PB); \
          for (int i = gt; i < M * PLE / 8; i += NGT) { const f32x4 a = *(const GAS f32x4*)(p + (size_t)i * 8), b = *(const GAS f32x4*)(p + (size_t)i * 8 + 4); \
              v4u o; o.x = pk2(a[0], a[1]); o.y = pk2(a[2], a[3]); o.z = pk2(b[0], b[1]); o.w = pk2(b[2], b[3]); *(GAS v4u*)(pbf + (size_t)i * 8) = o; } } } while (0)
    int sbuf = 0;
    for (int l = 0; l < DEPTH; ++l) {
        const int pb = 1 + l * PH_PER_LAYER;
        if (EN(11) && IN(pb + 0) && l == 0) {
            PHASE_BEGIN();
            LDS_WAIT(); __syncthreads();
            { int k_ = __builtin_amdgcn_readfirstlane((int)MISC[16 + wave]);
              for (int it_ = gw + k_ * NGW; it_ < I_LAYER; it_ += NGW) W_ITEM(it_, l, wl);
              if (lane == 0) MISC[16 + wave] = 0u; LDS_WAIT(); }
            CONV_PWF(l);
            SEAMF(pb + 0, l + 1, 0);
        }
        if (EN(0) && IN(pb + 1)) {
            PHASE_BEGIN();
            { const GAS float* wf = wfb; const GAS float* ssc = ssq + (size_t)sbuf * M * 32; const int row0 = cbx * 64 + wave * 8;
              const float bfv = INP(4)[l * 4 + (lane & 3)];
#pragma unroll 1
              for (int g4 = 0; g4 < 8; g4 += 4) {
                  v4u hw[4][4]; float spv[4];
#pragma unroll
                  for (int r = 0; r < 4; ++r) { const int row = row0 + g4 + r;
#pragma unroll
                      for (int j = 0; j < 4; ++j) hw[r][j] = *(const GAS v4u*)(hb1 + (size_t)row * DM + 512 * j + 8 * lane);
                      spv[r] = lane < 32 ? ssc[(size_t)row * 32 + lane] : 0.f; }
#pragma unroll
                  for (int r = 0; r < 4; ++r) { const int row = row0 + g4 + r; float d0 = 0.f, d1 = 0.f, d2 = 0.f, d3 = 0.f;
#pragma unroll
                      for (int j = 0; j < 4; ++j) { const int k0 = 512 * j + 8 * lane; const v4u w = hw[r][j];
                          const f32x4 a = {pg8::bf_lo(w.x), pg8::bf_hi(w.x), pg8::bf_lo(w.y), pg8::bf_hi(w.y)}, b = {pg8::bf_lo(w.z), pg8::bf_hi(w.z), pg8::bf_lo(w.w), pg8::bf_hi(w.w)};
                          f32x4 t;
                          t = a * *(const GAS f32x4*)(wf + k0) + b * *(const GAS f32x4*)(wf + k0 + 4); d0 += (t[0] + t[1]) + (t[2] + t[3]);
                          t = a * *(const GAS f32x4*)(wf + DM + k0) + b * *(const GAS f32x4*)(wf + DM + k0 + 4); d1 += (t[0] + t[1]) + (t[2] + t[3]);
                          t = a * *(const GAS f32x4*)(wf + 2 * DM + k0) + b * *(const GAS f32x4*)(wf + 2 * DM + k0 + 4); d2 += (t[0] + t[1]) + (t[2] + t[3]);
                          t = a * *(const GAS f32x4*)(wf + 3 * DM + k0) + b * *(const GAS f32x4*)(wf + 3 * DM + k0 + 4); d3 += (t[0] + t[1]) + (t[2] + t[3]); }
                      d0 = wave_sum(d0); d1 = wave_sum(d1); d2 = wave_sum(d2); d3 = wave_sum(d3);
                      const float sp = wave_sum(spv[r]);
                      const float rs = 1.0f / sqrtf(sp * (1.0f / DM) + NORM_EPS);
                      const float dd = (lane & 3) == 0 ? d0 : (lane & 3) == 1 ? d1 : (lane & 3) == 2 ? d2 : d3;
                      if (lane < 4) flog[(size_t)row * 4 + lane] = dd * rs + bfv; } } }
            pg8::Gemm g{hb1, (const GAS bf16*)(wl + WO_IN), M, NIN, DM, 0 PROFARG}; pg8::StaticOrder S; S.init(M, NIN, G, cbx);
            pg8::Unit u0; S.next(0, u0);
            RSTD_TABLE(u0.pm, ssq + (size_t)sbuf * M * 32);
            pg8::EpiIn E{qb, gates, INP(6) + (size_t)l * 4096, cst, rstd_l};
            pg8::gemm_phase<pg8::EpiIn, pg8::StaticOrder, true, true>(L + RING_OFF, g, S, E, wave);
            { int kpp = PLE; asm volatile("" : "+s"(kpp));
              pg8::Gemm g2{(const GAS bf16*)(wsx + WS_PB), (const GAS bf16*)(wl + WO_PLE), M, DM, kpp, 0 PROFARG}; pg8::StaticOrder S2; S2.init(M, DM, G, cbx);
              pg8::EpiOut<0> E2{ppb, DM, rstd_l};
              pg8::gemm_phase<pg8::EpiOut<0>, pg8::StaticOrder, true, true>(L + RING_OFF, g2, S2, E2, wave); }
            SEAMF(pb + 1, l + 1, 1);
        }
        if (EN(1) && IN(pb + 2)) {
            PHASE_BEGIN();
            {
            LAS char* al = (LAS char*)(L + RING_OFF);
            const int qbF = 7 - (cbx >> 5), col = cbx & 31, bF = col >> 2, hF = col & 3;
            att::Seam Sm; const att::Bases AB{qb, kbuf, vbuf};
            if (FAST_FOX) { att::Ref cur; cur.bo = (bF * SEQ) * DM + (12 + hF) * HD; cur.P0 = qbF * 256; cur.dlog = 0;
              att::fox_bias(flog + (size_t)bF * SEQ * 4 + hF, cur.P0 + 255, al, wave);
              att::blk_prime<true>(AB, cur, al, Sm, wave);
              att::blk_run<true>(AB, cur, cur, y2 + (size_t)bF * SEQ * 1024 + hF * HD, 1024, nullptr, al, Sm, wave); }
            { const int ndil = (0x11233455 >> (4 * qbF)) & 15; int off = 0; for (int q2 = 0; q2 < qbF; ++q2) off += (0x11233455 >> (4 * q2)) & 15;
#define DIL_REF(R, s_) do { const int du_ = (off + (s_)) * 32 + col, bg_ = du_ >> 5; (R).bo = ((bg_ / 3) * SEQ) * DM + ((bg_ % 3) * 4 + ((du_ >> 3) & 3)) * HD; (R).P0 = (du_ & 7) * 256; (R).dlog = 2 * (bg_ % 3); (R).du = du_; } while (0)
              if (FAST_DIL && ndil > 0) { att::Ref cur, nxt; DIL_REF(cur, 0);
                  att::blk_prime<false>(AB, cur, al, Sm, wave);
                  for (int s = 0; s < ndil; ++s) { if (s + 1 < ndil) DIL_REF(nxt, s + 1); else nxt = cur;
                      const int bg = cur.du >> 5, g_ = bg % 3, b_ = bg / 3, j_ = (cur.du >> 3) & 3;
                      att::blk_run<false>(AB, cur, nxt, og + (size_t)g_ * M * 512 + (size_t)b_ * SEQ * 512 + j_ * HD, 512, lse + (size_t)g_ * M * 4 + (size_t)b_ * SEQ * 4 + j_, al, Sm, wave); cur = nxt; } }
#undef DIL_REF
            }
            }
            SEAMF(pb + 2, l + 1, 2);
        }
        if (EN(2) && IN(pb + 3)) {
            PHASE_BEGIN();
#pragma unroll
            for (int i = 0; i < 8; ++i) { const size_t row = (size_t)cbx * 64 + wave * 8 + i; const int j = lane >> 4;
                const float l0 = lse[row * 4 + j], l1 = lse[(size_t)M * 4 + row * 4 + j], l2 = lse[(size_t)2 * M * 4 + row * 4 + j];
                const float mx = fmaxf(l0, fmaxf(l1, l2)); const float e0 = __expf(l0 - mx), e1 = __expf(l1 - mx), e2 = __expf(l2 - mx); const float inv = 1.0f / (e0 + e1 + e2);
                const v4u a = *(const GAS v4u*)(og + row * 512 + 8 * lane), b = *(const GAS v4u*)(og + (size_t)M * 512 + row * 512 + 8 * lane), c = *(const GAS v4u*)(og + (size_t)2 * M * 512 + row * 512 + 8 * lane);
                const float w0 = e0 * inv, w1 = e1 * inv, w2 = e2 * inv;
                v4u o;
#define MIX2(F) pk2(w0 * pg8::bf_lo(a.F) + w1 * pg8::bf_lo(b.F) + w2 * pg8::bf_lo(c.F), w0 * pg8::bf_hi(a.F) + w1 * pg8::bf_hi(b.F) + w2 * pg8::bf_hi(c.F))
                o.x = MIX2(x); o.y = MIX2(y); o.z = MIX2(z); o.w = MIX2(w);
#undef MIX2
                *(GAS v4u*)(y2 + row * 1024 + 512 + 8 * lane) = o; }
            if (l + 1 < DEPTH) CONV_PWF(l + 1);
            SEAMF(pb + 3, l + 1, 3);
        }
        if (EN(3) && IN(pb + 4)) {
            PHASE_BEGIN();
            pg8::Gemm g{y2, (const GAS bf16*)(wl + WO_BRB), M, DM, 1024, 0 PROFARG}; pg8::StaticOrder S; S.init(M, DM, G, cbx);
            pg8::EpiMerge E{gates, mrg};
            if (W_EARLY) W_PART(0);
            pg8::gemm_phase<pg8::EpiMerge, pg8::StaticOrder, true, true>(L + RING_OFF, g, S, E, wave);
            if (!W_EARLY) W_PART(0);
            SEAMF(pb + 4, l + 1, 4);
        }
        if (EN(4) && IN(pb + 5)) {
            PHASE_BEGIN();
            { pg8::Gemm g{mrg, (const GAS bf16*)(wl + WO_O), M, DM, DM, 0 PROFARG}; pg8::StaticOrder S; S.init(M, DM, G, cbx);
              pg8::EpiRes<0> E{hb1, hb0, ssq + (size_t)(sbuf ^ 1) * M * 32, nullptr, rstd_l};
              if (W_EARLY) W_PART(2);
              pg8::gemm_phase<pg8::EpiRes<0>, pg8::StaticOrder, true, true>(L + RING_OFF, g, S, E, wave);
              if (!W_EARLY) W_PART(2); }
            SEAMF(pb + 5, l + 1, 5);
        }
        sbuf ^= 1;
        if (EN(6) && IN(pb + 6)) {
            PHASE_BEGIN();
            pg8::Gemm g{hb0, (const GAS bf16*)(wl + WO_UP), M, DFF, DM, 0 PROFARG}; pg8::StaticOrder S; S.init(M, DFF, G, cbx);
            pg8::Unit u0; S.next(0, u0);
            RSTD_TABLE(u0.pm, ssq + (size_t)sbuf * M * 32);
            pg8::EpiOut<1> E{upb, DFF, rstd_l};
            pg8::gemm_phase<pg8::EpiOut<1>, pg8::StaticOrder, true, true>(L + RING_OFF, g, S, E, wave);
            SEAMF(pb + 6, l + 1, 6);
        }
        if (EN(7) && IN(pb + 7)) {
            PHASE_BEGIN();
            pg8::Gemm g{upb, (const GAS bf16*)(wl + WO_DOWN), M, DM, DFF, 1 PROFARG}; pg8::StaticOrder S; S.init(M, DM, G, cbx);
            pg8::EpiRes<0> E{hb0, hb0, ssq + (size_t)(sbuf ^ 1) * M * 32, nullptr, rstd_l};
            if (W_EARLY) W_PART(4);
            pg8::gemm_phase<pg8::EpiRes<0>, pg8::StaticOrder, true, true>(L + RING_OFF, g, S, E, wave);
            if (!W_EARLY) W_PART(4);
            SEAMF(pb + 7, l + 1, 7);
        }
        sbuf ^= 1;
        if (EN(8) && IN(pb + 8)) {
            PHASE_BEGIN();
            pg8::Gemm g{hb0, (const GAS bf16*)(wl + WO_PG), M, DM, DM, 0 PROFARG}; pg8::StaticOrder S; S.init(M, DM, G, cbx);
            if (W_EARLY) W_PART(6);
            pg8::Unit u0; S.next(0, u0);
            RSTD_TABLE(u0.pm, ssq + (size_t)sbuf * M * 32);
            pg8::EpiRes<1> E{hb0, hb1, ssq + (size_t)(sbuf ^ 1) * M * 32, ppb, rstd_l};
            pg8::gemm_phase<pg8::EpiRes<1>, pg8::StaticOrder, true, true>(L + RING_OFF, g, S, E, wave);
            if (!W_EARLY) W_PART(6);
            SEAMF(pb + 8, l + 1, 8);
        }
        sbuf ^= 1;
    }
    if (EN(10) && IN(N_PHASES - 1)) {
        PHASE_BEGIN();
        { const GAS float* gf = INP(16); const GAS float* ssc = ssq + (size_t)sbuf * M * 32;
#pragma unroll 2
        for (int m = gw; m < M; m += NGW) {
            float sp = lane < 32 ? ssc[(size_t)m * 32 + lane] : 0.f; sp = wave_sum(sp);
            const float rs = 1.0f / sqrtf(sp * (1.0f / DM) + NORM_EPS);
            const GAS v4u* hr = (const GAS v4u*)(hb1 + (size_t)m * DM); const GAS f32x4* gr = (const GAS f32x4*)gf; GAS f32x4* orow = (GAS f32x4*)(((GAS float*)INP(17)) + (size_t)m * DM);
#pragma unroll
            for (int j = 0; j < 4; ++j) { const v4u w = hr[64 * j + lane]; const f32x4 a = {pg8::bf_lo(w.x), pg8::bf_hi(w.x), pg8::bf_lo(w.y), pg8::bf_hi(w.y)}, b = {pg8::bf_lo(w.z), pg8::bf_hi(w.z), pg8::bf_lo(w.w), pg8::bf_hi(w.w)};
                orow[128 * j + 2 * lane] = a * rs * gr[128 * j + 2 * lane]; orow[128 * j + 2 * lane + 1] = b * rs * gr[128 * j + 2 * lane + 1]; }
        } }
    }
#undef IN
#undef SEAM
#undef SEAMF
#undef W_PART
#undef CONV_PWF
#undef W_EARLY
#undef W_ITEM
#undef RSTD_TABLE
#undef hbuf
#undef hb0
#undef hb1
#undef qb
#undef kbuf
#undef vbuf
#undef gates
#undef mrg
#undef upb
#undef ppb
#undef og
#undef y2
#undef flog
#undef lse
#undef ssq
#undef cst
#undef wfb
#undef wl
}

__global__ void mk_fail(float* out, int n) { const float q = __builtin_nanf(""); for (int i = blockIdx.x * blockDim.x + threadIdx.x; i < n; i += gridDim.x * blockDim.x) out[i] = q; }

extern "C" void kernel_launch(void* const* d_in, const int* in_sizes, int n_in, void* d_out, int out_size, void* d_ws, size_t ws_size, hipStream_t stream) {
    static int grid = 0;
    if (grid == 0) {
        if (n_in != 17 || in_sizes[0] != M * DM || out_size != M * DM || ws_size < WS_END) { fprintf(stderr, "kernel_launch: unexpected shapes (n_in %d, in0 %d, out %d, ws %zu < %zu)\n", n_in, n_in > 0 ? in_sizes[0] : -1, out_size, ws_size, (size_t)WS_END); grid = -1; return; }
        int dev = 0, cus = 0;
        if (hipGetDevice(&dev) != hipSuccess || hipDeviceGetAttribute(&cus, hipDeviceAttributeMultiprocessorCount, dev) != hipSuccess) { grid = -1; return; }
        if (hipFuncSetAttribute((const void*)mk_fwd, hipFuncAttributeMaxDynamicSharedMemorySize, LDS_BYTES) != hipSuccess) { fprintf(stderr, "kernel_launch: hipFuncSetAttribute failed\n"); grid = -1; return; }
        int per_cu = 0;
        if (hipOccupancyMaxActiveBlocksPerMultiprocessor(&per_cu, (const void*)mk_fwd, NWAVES * 64, LDS_BYTES) != hipSuccess || per_cu < 1) fprintf(stderr, "kernel_launch: occupancy query says %d\n", per_cu);
        (void)hipGetLastError();
        if (cus < 256) { fprintf(stderr, "kernel_launch: needs 256 CUs, device has %d\n", cus); grid = -1; return; }
        grid = 256;
    }
    if (grid < 0) { hipLaunchKernelGGL(mk_fail, dim3(1024), dim3(256), 0, stream, (float*)d_out, out_size); return; }
    (void)hipMemsetAsync((char*)d_ws + WS_CTL, 0, CTL_ZERO_BYTES, stream);
    Args a{};
    for (int i = 0; i < 17; ++i) a.in[i] = (const float*)d_in[i];
    a.out = (float*)d_out; a.ws = (unsigned char*)d_ws;
#if MK_SINGLE
    a.ph_lo = 0; a.ph_hi = N_PHASES;
    hipLaunchKernelGGL(mk_fwd, dim3(grid), dim3(NWAVES * 64), LDS_BYTES, stream, a);
#else
    for (int p = 0; p < N_PHASES; ++p) { a.ph_lo = p; a.ph_hi = p + 1;
        hipLaunchKernelGGL(mk_fwd, dim3(grid), dim3(NWAVES * 64), LDS_BYTES, stream, a);
    }
#endif
}
```

```cpp
#define MK_SINGLE 1
#include <hip/hip_runtime.h>
#include <cstdio>
#include <cstdint>
namespace pg8 {
#define PG8_LAS __attribute__((address_space(3)))
#define PG8_GAS __attribute__((address_space(1)))
typedef unsigned short bf16_t;
typedef short bf16x8 __attribute__((ext_vector_type(8)));
typedef float f32x4 __attribute__((ext_vector_type(4)));
typedef unsigned u32x4 __attribute__((ext_vector_type(4)));
constexpr int BM = 256, BK = 64, HALF = 128, HTB = HALF * BK * 2  , STAGE_BYTES = 8 * HTB, NXCD = 8, WGM = 8;

__host__ __device__ __forceinline__ int lds_byte(int r, int c) { const int st = (r >> 4) * 2 + (c >> 5), rr = r & 15, cc = c & 31, ob = rr * 64 + cc * 2; return st * 1024 + (ob ^ (((ob >> 9) & 1) << 5)); }
__host__ __device__ __forceinline__ void stage_rc(int b, int& R, int& C) { const int st = b / 1024, sb = b % 1024, swz = sb ^ (((sb >> 9) & 1) << 5); R = (st >> 1) * 16 + swz / 64; C = (st & 1) * 32 + (swz % 64) / 2; }
__host__ __device__ __forceinline__ int perm32(int rho) { const int n = rho >> 4, i = rho & 15; return 8 * (i >> 2) + 4 * n + (i & 3); }

struct Unit { int pm, pn; };
struct Gemm { const PG8_GAS bf16_t* A; const PG8_GAS bf16_t* Bt; int M, N, K; int kdir;
};

struct StaticOrder {
    int nM, nN, nwg, G, c;
    __host__ __device__ __forceinline__ void init(int M, int N, int G_, int c_) { nM = M / BM; nN = N / BM; nwg = nM * nN; G = G_; c = c_; }
    __host__ __device__ __forceinline__ bool next(int i, Unit& u) const {
        const long L = (long)i * G + c; if (L >= nwg) return false;
        int wgid = (int)L; { const int q = nwg / NXCD, r = nwg % NXCD, xcd = wgid % NXCD, off = wgid / NXCD; wgid = (xcd < r ? xcd * (q + 1) : r * (q + 1) + (xcd - r) * q) + off; }
        const int nig = WGM * nN, gid = wgid / nig, fm = gid * WGM, gsz = (nM - fm) < WGM ? (nM - fm) : WGM;
        u.pm = fm + ((wgid % nig) % gsz); u.pn = (wgid % nig) / gsz; return true;
    }
    __device__ __forceinline__ void a_ready(const Unit&) const {}
    __device__ __forceinline__ void done(const Unit&) const {}
};

typedef __bf16 bf16x2_nat __attribute__((ext_vector_type(2)));
typedef float f32x2_nat __attribute__((ext_vector_type(2)));
__device__ __forceinline__ unsigned cvt_pk_bf16(float lo, float hi) { const f32x2_nat v = {lo, hi}; const bf16x2_nat b = __builtin_convertvector(v, bf16x2_nat); return __builtin_bit_cast(unsigned, b); }
typedef float f32x2 __attribute__((ext_vector_type(2)));
__device__ __forceinline__ int mk_lane() { unsigned m = ~0u; asm volatile("" : "+s"(m)); return (int)__builtin_amdgcn_mbcnt_hi(m, __builtin_amdgcn_mbcnt_lo(m, 0u)); }
__device__ __forceinline__ float xl_xor1(float v) { return __int_as_float(__builtin_amdgcn_update_dpp(0, __float_as_int(v), 0xB1, 0xf, 0xf, true)); }
__device__ __forceinline__ float xl_xor2(float v) { return __int_as_float(__builtin_amdgcn_update_dpp(0, __float_as_int(v), 0x4E, 0xf, 0xf, true)); }
template <int K> __device__ __forceinline__ float xl_swz(float v) { return __int_as_float(__builtin_amdgcn_ds_swizzle(__float_as_int(v), (K << 10) | 0x1f)); }
__device__ __forceinline__ float xl_sum32(float v) { auto r = __builtin_amdgcn_permlane32_swap(__float_as_uint(v), __float_as_uint(v), false, false); return __uint_as_float(r[0]) + __uint_as_float(r[1]); }
__device__ __forceinline__ float xl_other32(float v, bool low_half) { auto r = __builtin_amdgcn_permlane32_swap(__float_as_uint(v), __float_as_uint(v), false, false); return __uint_as_float(low_half ? r[1] : r[0]); }
__device__ __forceinline__ float xl_wave_sum(float v) { v += xl_xor1(v); v += xl_xor2(v); v += xl_swz<4>(v); v += xl_swz<8>(v); v += xl_swz<16>(v); return xl_sum32(v); }
__device__ __forceinline__ float bf_lo(unsigned w) { return __uint_as_float(w << 16); }
__device__ __forceinline__ float bf_hi(unsigned w) { return __uint_as_float(w & 0xffff0000u); }
__device__ __forceinline__ float h_lo(unsigned w) { return (float)__builtin_bit_cast(_Float16, (unsigned short)(w & 0xffffu)); }
__device__ __forceinline__ float h_hi(unsigned w) { return (float)__builtin_bit_cast(_Float16, (unsigned short)(w >> 16)); }
__device__ __forceinline__ float sigmoid_f(float x) { return __builtin_amdgcn_rcpf(1.0f + __builtin_amdgcn_exp2f(-1.4426950408889634f * x)); }
__device__ __forceinline__ u32x4 pack8_bf16(const f32x4& v0, const f32x4& v1) { u32x4 w; w.x = cvt_pk_bf16(v0[0], v0[1]); w.y = cvt_pk_bf16(v0[2], v0[3]); w.z = cvt_pk_bf16(v1[0], v1[1]); w.w = cvt_pk_bf16(v1[2], v1[3]); return w; }
__device__ __forceinline__ void unpack8_bf16(const u32x4& w, f32x4& a, f32x4& b) { a = (f32x4){bf_lo(w.x), bf_hi(w.x), bf_lo(w.y), bf_hi(w.y)}; b = (f32x4){bf_lo(w.z), bf_hi(w.z), bf_lo(w.w), bf_hi(w.w)}; }

struct EpiIn {
    static constexpr bool PERM = true, AFTER_DRAIN = false; static constexpr int MIDT = 0;
    PG8_GAS bf16_t* qkv; PG8_GAS bf16_t* gates; const PG8_GAS float* bgate; const PG8_GAS float* cs; const PG8_LAS float* rstd;
    __device__ __forceinline__ void operator()(const f32x4 (&acc)[2][2][4][2], const Unit& u, int wr, int wc, int fr, int fq) const {
        const int lr0 = wr * 64 + fr, cw = wc * 32 + 8 * fq;
        if (u.pn < 24) {
            const int region = u.pn >> 3, pt = u.pn & 7;
            PG8_GAS bf16_t* base = qkv + (size_t)region * ((size_t)16384 * 2048);
            const bool rope = (region < 2) && (pt < 6) && (wc == 0);
            const float sg = fq < 2 ? -1.f : 1.f;
            if (!rope) {
#pragma unroll
                for (int ai = 0; ai < 2; ++ai)
#pragma unroll
                    for (int m = 0; m < 4; ++m) {
                        const int lr = lr0 + ai * HALF + m * 16; const float rs = rstd[lr];
                        PG8_GAS bf16_t* rowp = base + ((size_t)u.pm * BM + lr) * 2048 + pt * 256 + cw;
                        *(PG8_GAS u32x4*)rowp = pack8_bf16(acc[ai][0][m][0] * rs, acc[ai][0][m][1] * rs);
                        *(PG8_GAS u32x4*)(rowp + HALF) = pack8_bf16(acc[ai][1][m][0] * rs, acc[ai][1][m][1] * rs);
                    }
            } else
#pragma unroll
            for (int ai = 0; ai < 2; ++ai) {
                u32x4 cw4[4][2];
                if (rope) {
#pragma unroll
                    for (int m = 0; m < 4; ++m) { const PG8_GAS u32x4* cp = (const PG8_GAS u32x4*)((const PG8_GAS unsigned*)cs + (((size_t)u.pm * BM + lr0 + ai * HALF + m * 16) & 2047) * 16 + (fq & 1) * 8);
                        cw4[m][0] = cp[0]; cw4[m][1] = cp[1]; } }
#pragma unroll
                for (int m = 0; m < 4; ++m) {
                    const int lr = lr0 + ai * HALF + m * 16; const size_t row = (size_t)u.pm * BM + lr; const float rs = rstd[lr];
                    PG8_GAS bf16_t* rowp = base + row * 2048 + pt * 256 + cw;
                    f32x4 c0 = {1.f, 0.f, 1.f, 0.f}, c1 = c0, c2 = c0, c3 = c0;
                    if (rope) { const u32x4 a_ = cw4[m][0], b_ = cw4[m][1];
                        c0 = (f32x4){h_lo(a_.x), h_hi(a_.x), h_lo(a_.y), h_hi(a_.y)}; c1 = (f32x4){h_lo(a_.z), h_hi(a_.z), h_lo(a_.w), h_hi(a_.w)};
                        c2 = (f32x4){h_lo(b_.x), h_hi(b_.x), h_lo(b_.y), h_hi(b_.y)}; c3 = (f32x4){h_lo(b_.z), h_hi(b_.z), h_lo(b_.w), h_hi(b_.w)}; }
#pragma unroll
                    for (int bj = 0; bj < 2; ++bj) {
                        f32x4 v0 = acc[ai][bj][m][0] * rs, v1 = acc[ai][bj][m][1] * rs;
                        if (rope) {
                            f32x4 o0, o1;
#pragma unroll
                            for (int e = 0; e < 4; ++e) { o0[e] = xl_other32(v0[e], fq < 2); o1[e] = xl_other32(v1[e], fq < 2); }
                            v0 = (f32x4){v0[0] * c0[0] + sg * o0[0] * c0[1], v0[1] * c0[2] + sg * o0[1] * c0[3], v0[2] * c1[0] + sg * o0[2] * c1[1], v0[3] * c1[2] + sg * o0[3] * c1[3]};
                            v1 = (f32x4){v1[0] * c2[0] + sg * o1[0] * c2[1], v1[1] * c2[2] + sg * o1[1] * c2[3], v1[2] * c3[0] + sg * o1[2] * c3[1], v1[3] * c3[2] + sg * o1[3] * c3[3]};
                        }
                        *(PG8_GAS u32x4*)(rowp + bj * HALF) = pack8_bf16(v0, v1);
                    }
                    asm volatile("" ::: "memory");
                }
            }
        } else {
            const int gc = (u.pn - 24) * 128 + cw;
            const f32x4 bv00 = *(const PG8_GAS f32x4*)(bgate + gc), bv01 = *(const PG8_GAS f32x4*)(bgate + gc + 4), bv10 = *(const PG8_GAS f32x4*)(bgate + 2048 + gc), bv11 = *(const PG8_GAS f32x4*)(bgate + 2048 + gc + 4);
#pragma unroll
            for (int ai = 0; ai < 2; ++ai)
#pragma unroll
                for (int m = 0; m < 4; ++m) {
                    const int lr = lr0 + ai * HALF + m * 16; const size_t row = (size_t)u.pm * BM + lr; const float rs = rstd[lr];
                    PG8_GAS bf16_t* rowp = gates + row * 4096 + gc;
                    f32x4 a0 = acc[ai][0][m][0] * rs + bv00, a1 = acc[ai][0][m][1] * rs + bv01, b0 = acc[ai][1][m][0] * rs + bv10, b1 = acc[ai][1][m][1] * rs + bv11;
#pragma unroll
                    for (int e = 0; e < 4; ++e) { a0[e] = sigmoid_f(a0[e]); a1[e] = sigmoid_f(a1[e]); b0[e] = sigmoid_f(b0[e]); b1[e] = sigmoid_f(b1[e]); }
                    const u32x4 ga = pack8_bf16(a0, a1); unpack8_bf16(ga, a0, a1);
#pragma unroll
                    for (int e = 0; e < 4; ++e) { b0[e] *= __builtin_amdgcn_rcpf(a0[e]); b1[e] *= __builtin_amdgcn_rcpf(a1[e]); }
                    *(PG8_GAS u32x4*)rowp = ga;
                    *(PG8_GAS u32x4*)(rowp + 2048) = pack8_bf16(b0, b1);
                }
        }
    }
};

template <bool HAS_ADD> struct EpiGate {
    static constexpr bool PERM = true, AFTER_DRAIN = false; static constexpr int MIDT = 0;
    const PG8_GAS bf16_t* gate; const PG8_GAS bf16_t* add; PG8_GAS bf16_t* out;
    __device__ __forceinline__ void operator()(const f32x4 (&acc)[2][2][4][2], const Unit& u, int wr, int wc, int fr, int fq) const {
        const int lr0 = wr * 64 + fr, col0 = u.pn * BM + wc * 32 + 8 * fq;
#pragma unroll
        for (int ai = 0; ai < 2; ++ai) {
            u32x4 gw[4][2], aw[4][2];
#pragma unroll
            for (int m = 0; m < 4; ++m)
#pragma unroll
                for (int bj = 0; bj < 2; ++bj) { const size_t row = (size_t)u.pm * BM + lr0 + ai * HALF + m * 16; const int col = col0 + bj * HALF;
                    gw[m][bj] = *(const PG8_GAS u32x4*)(gate + row * 4096 + col);
                    if (HAS_ADD) aw[m][bj] = *(const PG8_GAS u32x4*)(add + row * 2048 + col); }
#pragma unroll
            for (int m = 0; m < 4; ++m)
#pragma unroll
                for (int bj = 0; bj < 2; ++bj) { const size_t row = (size_t)u.pm * BM + lr0 + ai * HALF + m * 16; const int col = col0 + bj * HALF;
                    f32x4 g0, g1; unpack8_bf16(gw[m][bj], g0, g1);
                    f32x4 v0 = g0 * acc[ai][bj][m][0], v1 = g1 * acc[ai][bj][m][1];
                    if (HAS_ADD) { f32x4 a0, a1; unpack8_bf16(aw[m][bj], a0, a1); v0 += a0; v1 += a1; }
                    *(PG8_GAS u32x4*)(out + row * 2048 + col) = pack8_bf16(v0, v1); }
            asm volatile("" ::: "memory");
        }
    }
};

struct EpiMerge {
    static constexpr bool PERM = true, AFTER_DRAIN = false; static constexpr int MIDT = 8;
    const PG8_GAS bf16_t* gates; PG8_GAS bf16_t* out;
    __device__ __forceinline__ void mid(f32x4 (&acc)[2][2][4][2], const Unit& u, int wr, int wc, int fr, int fq) const {
        const int lr0 = wr * 64 + fr, col0 = u.pn * BM + wc * 32 + 8 * fq;
        u32x4 r[2][4][2];
#pragma unroll
        for (int ai = 0; ai < 2; ++ai)
#pragma unroll
            for (int m = 0; m < 4; ++m)
#pragma unroll
                for (int bj = 0; bj < 2; ++bj) r[ai][m][bj] = *(const PG8_GAS u32x4*)(gates + ((size_t)u.pm * BM + lr0 + ai * HALF + m * 16) * 4096 + 2048 + col0 + bj * HALF);
#pragma unroll
        for (int ai = 0; ai < 2; ++ai)
#pragma unroll
            for (int m = 0; m < 4; ++m)
#pragma unroll
                for (int bj = 0; bj < 2; ++bj) { f32x4 r0, r1; unpack8_bf16(r[ai][m][bj], r0, r1); acc[ai][bj][m][0] *= r0; acc[ai][bj][m][1] *= r1; }
        asm volatile("" ::: "memory");
    }
    __device__ __forceinline__ void operator()(const f32x4 (&acc)[2][2][4][2], const Unit& u, int wr, int wc, int fr, int fq) const {
        const int lr0 = wr * 64 + fr, col0 = u.pn * BM + wc * 32 + 8 * fq;
#pragma unroll
        for (int ai = 0; ai < 2; ++ai) {
            u32x4 ga[4][2];
#pragma unroll
            for (int m = 0; m < 4; ++m)
#pragma unroll
                for (int bj = 0; bj < 2; ++bj) ga[m][bj] = *(const PG8_GAS u32x4*)(gates + ((size_t)u.pm * BM + lr0 + ai * HALF + m * 16) * 4096 + col0 + bj * HALF);
#pragma unroll
            for (int m = 0; m < 4; ++m)
#pragma unroll
                for (int bj = 0; bj < 2; ++bj) { f32x4 a0, a1; unpack8_bf16(ga[m][bj], a0, a1);
                    *(PG8_GAS u32x4*)(out + ((size_t)u.pm * BM + lr0 + ai * HALF + m * 16) * 2048 + col0 + bj * HALF) = pack8_bf16(a0 * acc[ai][bj][m][0], a1 * acc[ai][bj][m][1]); }
            asm volatile("" ::: "memory");
        }
    }
};

template <int MODE> struct EpiRes {
    static constexpr bool PERM = true, AFTER_DRAIN = false; static constexpr int MIDT = 0;
    const PG8_GAS bf16_t* res; PG8_GAS bf16_t* hb; PG8_GAS float* ssq; const PG8_GAS bf16_t* pp; const PG8_LAS float* rstd;
    __device__ __forceinline__ void operator()(const f32x4 (&acc)[2][2][4][2], const Unit& u, int wr, int wc, int fr, int fq) const {
        const int lr0 = wr * 64 + fr, col0 = u.pn * BM + wc * 32 + 8 * fq;
        constexpr int NB = 4;
#pragma unroll
        for (int g0 = 0; g0 < 8; g0 += NB) {
            u32x4 rw[NB][2], pw[NB][2];
#pragma unroll
            for (int gi = 0; gi < NB; ++gi)
#pragma unroll
                for (int bj = 0; bj < 2; ++bj) { const int ai = (g0 + gi) >> 2, m = (g0 + gi) & 3; const size_t o = ((size_t)u.pm * BM + lr0 + ai * HALF + m * 16) * 2048 + col0 + bj * HALF;
                    rw[gi][bj] = *(const PG8_GAS u32x4*)(res + o);
                    if (MODE == 1) pw[gi][bj] = *(const PG8_GAS u32x4*)(pp + o); }
#pragma unroll
            for (int gi = 0; gi < NB; ++gi) { const int ai = (g0 + gi) >> 2, m = (g0 + gi) & 3; const int lr = lr0 + ai * HALF + m * 16; const size_t row = (size_t)u.pm * BM + lr;
                float rs = 1.f; if (MODE == 1) rs = rstd[lr];
                float s = 0.f;
#pragma unroll
                for (int bj = 0; bj < 2; ++bj) { const size_t o = row * 2048 + col0 + bj * HALF;
                    f32x4 x0 = acc[ai][bj][m][0], x1 = acc[ai][bj][m][1];
                    if (MODE == 1) { f32x4 p0, p1; unpack8_bf16(pw[gi][bj], p0, p1);
#pragma unroll
                        for (int e = 0; e < 4; ++e) { x0[e] = sigmoid_f(x0[e] * rs) * p0[e]; x1[e] = sigmoid_f(x1[e] * rs) * p1[e]; } }
                    f32x4 r0, r1; unpack8_bf16(rw[gi][bj], r0, r1);
                    const f32x4 h0 = r0 + x0, h1 = r1 + x1;
                    *(PG8_GAS u32x4*)(hb + o) = pack8_bf16(h0, h1);
                    s += (h0[0] * h0[0] + h0[1] * h0[1]) + (h0[2] * h0[2] + h0[3] * h0[3]) + (h1[0] * h1[0] + h1[1] * h1[1]) + (h1[2] * h1[2] + h1[3] * h1[3]); }
                s += xl_swz<16>(s); s = xl_sum32(s);
                if (fq == 0) ssq[row * 32 + u.pn * 4 + wc] = s; }
            asm volatile("" ::: "memory");
        }
    }
};

template <int ACT> struct EpiOut {
    static constexpr bool PERM = true, AFTER_DRAIN = false; static constexpr int MIDT = 0;
    PG8_GAS bf16_t* out; int ldc; const PG8_LAS float* rstd;
    __device__ __forceinline__ void operator()(const f32x4 (&acc)[2][2][4][2], const Unit& u, int wr, int wc, int fr, int fq) const {
        const int lr0 = wr * 64 + fr, col0 = u.pn * BM + wc * 32 + 8 * fq;
#pragma unroll
        for (int ai = 0; ai < 2; ++ai)
#pragma unroll
            for (int m = 0; m < 4; ++m) {
                const int lr = lr0 + ai * HALF + m * 16; const size_t row = (size_t)u.pm * BM + lr;
                float rs = 1.f; if (ACT == 1) rs = rstd[lr];
                PG8_GAS bf16_t* rowp = out + row * ldc + col0;
#pragma unroll
                for (int bj = 0; bj < 2; ++bj) {
                    f32x4 v0 = acc[ai][bj][m][0], v1 = acc[ai][bj][m][1];
                    if (ACT == 1) {
#pragma unroll
                        for (int e = 0; e < 4; ++e) { const float a = fmaxf(v0[e] * rs, 0.f), b = fmaxf(v1[e] * rs, 0.f); v0[e] = a * a; v1[e] = b * b; }
                    }
                    *(PG8_GAS u32x4*)(rowp + bj * HALF) = pack8_bf16(v0, v1);
                }
            }
    }
};
template <class Epi, class Sched, bool ALIGN_EPI = false, bool SP2 = false>
__device__ __forceinline__ void gemm_phase(PG8_LAS unsigned char* lds, const Gemm g, const Sched& S, const Epi& E, const int wv  ) {
    const int lane_ = mk_lane();
    const int tid = wv * 64 + lane_, wid = wv, lane = lane_, wr = wid >> 2, wc = wid & 3, fr = lane & 15, fq = lane >> 4;
    const int K = g.K, nt = K / BK;
    unsigned voffA[2], voffB[2];
#pragma unroll
    for (int i = 0; i < 2; ++i) { int R, C; stage_rc(tid * 16 + i * 8192, R, C); const int Rb = Epi::PERM ? ((R & ~31) + perm32(R & 31)) : R;
        voffA[i] = (unsigned)(R * K + C) * 2u; voffB[i] = (unsigned)(Rb * K + C) * 2u; }
    const long kfw = (long)(BK * 2);
    const size_t hstep = (size_t)HALF * K * 2;
    const size_t tstep = 2 * hstep;
    const unsigned ldsw = (unsigned)wid * 1024u;
    const int aoff = lds_byte(wr * 64 + fr, fq * 8), boff = lds_byte(wc * 32 + fr, fq * 8);
#define PG8_SA(b, h) (((b) * 2 + (h)) * HTB)
#define PG8_SB(b, h) ((4 + (b) * 2 + (h)) * HTB)
#define PG8_STAGE(bufoff, gbase, voff) do { _Pragma("unroll") for (int _i = 0; _i < 2; ++_i) \
        __builtin_amdgcn_global_load_lds((const PG8_GAS unsigned*)((const PG8_GAS char*)(gbase) + (voff)[_i]), (PG8_LAS unsigned*)(lds + (bufoff) + ldsw + _i * 8192), 16, 0, 0); } while (0)
#define PG8_LDA(dst, b, h) do { _Pragma("unroll") for (int m = 0; m < 4; ++m) _Pragma("unroll") for (int k = 0; k < 2; ++k) dst[m][k] = *(const PG8_LAS bf16x8*)(lds + PG8_SA(b, h) + aoff + m * 2048 + k * 1024); } while (0)
#define PG8_LDB(dst, b, h) do { _Pragma("unroll") for (int n = 0; n < 2; ++n) _Pragma("unroll") for (int k = 0; k < 2; ++k) dst[n][k] = *(const PG8_LAS bf16x8*)(lds + PG8_SB(b, h) + boff + n * 2048 + k * 1024); } while (0)
#define PG8_MMA(ai, bj, At, Bt) do { __builtin_amdgcn_s_setprio(1); _Pragma("unroll") for (int m = 0; m < 4; ++m) _Pragma("unroll") for (int n = 0; n < 2; ++n) _Pragma("unroll") for (int k = 0; k < 2; ++k) \
        acc[ai][bj][m][n] = __builtin_amdgcn_mfma_f32_16x16x32_bf16(Bt[n][k], At[m][k], acc[ai][bj][m][n], 0, 0, 0); __builtin_amdgcn_s_setprio(0); } while (0)
#define PG8_WAIT_V(n) asm volatile("s_waitcnt vmcnt(" #n ")" ::: "memory")
#define PG8_WAIT_L(n) asm volatile("s_waitcnt lgkmcnt(" #n ")" ::: "memory")
#define PG8_BAR __builtin_amdgcn_s_barrier()
#define PG8_SCHED __builtin_amdgcn_sched_barrier(0)
    Unit cur, nxt; int ui = 0;
    if (!S.next(0, cur)) return;
    f32x4 acc[2][2][4][2];
#pragma unroll
    for (int a = 0; a < 2; ++a)
#pragma unroll
        for (int b = 0; b < 2; ++b)
#pragma unroll
            for (int m = 0; m < 4; ++m)
#pragma unroll
                for (int n = 0; n < 2; ++n) acc[a][b][m][n] = (f32x4){0.f, 0.f, 0.f, 0.f};
    bf16x8 At[4][2], B0[2][2], B1[2][2];
    const bool rev0 = g.kdir != 0; long kstep = rev0 ? -kfw : kfw;
    const PG8_GAS char* cA = (const PG8_GAS char*)g.A + (size_t)cur.pm * tstep + (rev0 ? (long)(nt - 1) * kfw : 0); const PG8_GAS char* cB = (const PG8_GAS char*)g.Bt + (size_t)cur.pn * tstep + (rev0 ? (long)(nt - 1) * kfw : 0);
    S.a_ready(cur);
    if constexpr (SP2) {
        PG8_STAGE(PG8_SB(0, 0), cB, voffB); PG8_STAGE(PG8_SB(0, 1), cB + hstep, voffB); PG8_STAGE(PG8_SA(0, 0), cA, voffA); PG8_STAGE(PG8_SA(0, 1), cA + hstep, voffA);
        if (wr == 1) PG8_BAR;
        PG8_WAIT_V(2); PG8_BAR;
        PG8_STAGE(PG8_SB(1, 0), cB + kstep, voffB); PG8_STAGE(PG8_SA(1, 0), cA + kstep, voffA); PG8_STAGE(PG8_SB(1, 1), cB + hstep + kstep, voffB);
        PG8_WAIT_V(6); PG8_BAR;
    } else {
        PG8_STAGE(PG8_SB(0, 0), cB, voffB); PG8_STAGE(PG8_SA(0, 0), cA, voffA); PG8_STAGE(PG8_SB(0, 1), cB + hstep, voffB); PG8_STAGE(PG8_SA(0, 1), cA + hstep, voffA);
        if (wr == 1) PG8_BAR;
        PG8_WAIT_V(4); PG8_BAR;
        PG8_STAGE(PG8_SB(1, 0), cB + kstep, voffB); PG8_STAGE(PG8_SA(1, 0), cA + kstep, voffA); PG8_STAGE(PG8_SB(1, 1), cB + hstep + kstep, voffB);
        PG8_WAIT_V(6); PG8_BAR;
    }
    for (;;) {
        const bool has_next = S.next(ui + 1, nxt);
        const bool revn = g.kdir != 0 && ((ui + 1) & 1) == 0; const long kstepn = has_next ? (revn ? -kfw : kfw) : kstep;
        const PG8_GAS char* nA = has_next ? (const PG8_GAS char*)g.A + (size_t)nxt.pm * tstep + (revn ? (long)(nt - 1) * kfw : 0) : cA; const PG8_GAS char* nB = has_next ? (const PG8_GAS char*)g.Bt + (size_t)nxt.pn * tstep + (revn ? (long)(nt - 1) * kfw : 0) : cB;
        for (int t = 0; t < nt; t += 2) {
            const bool last = (t == nt - 2);
            const PG8_GAS char* a1 = cA + (long)(t + 1) * kstep;
            const PG8_GAS char* a2 = last ? nA : cA + (long)(t + 2) * kstep; const PG8_GAS char* b2 = last ? nB : cB + (long)(t + 2) * kstep;
            const long ks3 = last ? kstepn : kstep; const PG8_GAS char* a3 = a2 + ks3; const PG8_GAS char* b3 = b2 + ks3;
            if (last && has_next) S.a_ready(nxt);
            if constexpr (SP2) {
            PG8_LDB(B0, 0, 0); PG8_LDB(B1, 0, 1); PG8_SCHED; PG8_LDA(At, 0, 0); PG8_STAGE(PG8_SA(1, 1), a1 + hstep, voffA);
            PG8_WAIT_V(8); PG8_WAIT_L(0); PG8_BAR; PG8_MMA(0, 0, At, B0); PG8_MMA(0, 1, At, B1); PG8_BAR; PG8_SCHED;
            PG8_LDA(At, 0, 1); PG8_STAGE(PG8_SB(0, 0), b2, voffB); PG8_STAGE(PG8_SB(0, 1), b2 + hstep, voffB); PG8_STAGE(PG8_SA(0, 0), a2, voffA);
            PG8_WAIT_V(8); PG8_WAIT_L(0); PG8_BAR; PG8_MMA(1, 0, At, B0); PG8_MMA(1, 1, At, B1); PG8_BAR; PG8_SCHED;
            PG8_LDB(B0, 1, 0); PG8_LDB(B1, 1, 1); PG8_SCHED; PG8_LDA(At, 1, 0); PG8_STAGE(PG8_SA(0, 1), a2 + hstep, voffA);
            PG8_WAIT_V(8); PG8_WAIT_L(0); PG8_BAR; PG8_MMA(0, 0, At, B0); PG8_MMA(0, 1, At, B1); PG8_BAR; PG8_SCHED;
            PG8_LDA(At, 1, 1); PG8_STAGE(PG8_SB(1, 0), b3, voffB); PG8_STAGE(PG8_SB(1, 1), b3 + hstep, voffB); PG8_STAGE(PG8_SA(1, 0), a3, voffA);
            PG8_WAIT_V(8); PG8_WAIT_L(0); PG8_BAR; PG8_MMA(1, 0, At, B0); PG8_MMA(1, 1, At, B1); PG8_BAR; PG8_SCHED;
            } else {
            PG8_LDB(B0, 0, 0); PG8_SCHED; PG8_LDA(At, 0, 0); PG8_STAGE(PG8_SA(1, 1), a1 + hstep, voffA);
            PG8_WAIT_L(8); PG8_BAR; PG8_WAIT_L(0); PG8_MMA(0, 0, At, B0); PG8_BAR; PG8_SCHED;
            PG8_LDB(B1, 0, 1); PG8_STAGE(PG8_SB(0, 0), b2, voffB);
            PG8_BAR; PG8_WAIT_L(0); PG8_MMA(0, 1, At, B1); PG8_BAR;
            PG8_LDA(At, 0, 1); PG8_STAGE(PG8_SA(0, 0), a2, voffA);
            PG8_BAR; PG8_WAIT_L(0); PG8_MMA(1, 0, At, B0); PG8_BAR; PG8_SCHED;
            PG8_STAGE(PG8_SB(0, 1), b2 + hstep, voffB);
            PG8_WAIT_V(6); PG8_BAR; PG8_MMA(1, 1, At, B1); PG8_BAR;
            PG8_LDB(B0, 1, 0); PG8_SCHED; PG8_LDA(At, 1, 0); PG8_STAGE(PG8_SA(0, 1), a2 + hstep, voffA);
            PG8_WAIT_L(8); PG8_BAR; PG8_WAIT_L(0); PG8_MMA(0, 0, At, B0); PG8_BAR; PG8_SCHED;
            PG8_LDB(B1, 1, 1); PG8_STAGE(PG8_SB(1, 0), b3, voffB);
            PG8_BAR; PG8_WAIT_L(0); PG8_MMA(0, 1, At, B1); PG8_BAR;
            PG8_LDA(At, 1, 1); PG8_STAGE(PG8_SA(1, 0), a3, voffA);
            PG8_BAR; PG8_WAIT_L(0); PG8_MMA(1, 0, At, B0); PG8_BAR; PG8_SCHED;
            PG8_STAGE(PG8_SB(1, 1), b3 + hstep, voffB);
            PG8_WAIT_V(6); PG8_BAR; PG8_MMA(1, 1, At, B1); PG8_BAR;
            }
            if constexpr (Epi::MIDT > 0) { if (t + 2 == Epi::MIDT) { int lm_ = lane; asm volatile("" : "+v"(lm_)); E.mid(acc, cur, wr, wc, lm_ & 15, lm_ >> 4); } }
        }
        if constexpr (ALIGN_EPI) { if (wr == 0) PG8_BAR; }
        if constexpr (!Epi::AFTER_DRAIN) { int lz_ = lane; asm volatile("" : "+v"(lz_));
            E(acc, cur, wr, wc, lz_ & 15, lz_ >> 4); S.done(cur); }
        if (!has_next) break;
#pragma unroll
        for (int a = 0; a < 2; ++a)
#pragma unroll
            for (int b = 0; b < 2; ++b)
#pragma unroll
                for (int m = 0; m < 4; ++m)
#pragma unroll
                    for (int n = 0; n < 2; ++n) acc[a][b][m][n] = (f32x4){0.f, 0.f, 0.f, 0.f};
        cur = nxt; cA = nA; cB = nB; kstep = kstepn; ++ui;
        if constexpr (ALIGN_EPI) { if (wr == 1) PG8_BAR; }
    }
    PG8_WAIT_V(0);
    if constexpr (!ALIGN_EPI) { if (wr == 0) PG8_BAR; }
    PG8_BAR;
    if constexpr (Epi::AFTER_DRAIN) { E.fused(acc, cur, wr, wc, fr, fq, lds, wid, lane); S.done(cur); }
#undef PG8_SA
#undef PG8_SB
#undef PG8_STAGE
#undef PG8_LDA
#undef PG8_LDB
#undef PG8_MMA
#undef PG8_WAIT_V
#undef PG8_WAIT_L
#undef PG8_BAR
#undef PG8_SCHED
}
}
namespace att {
typedef unsigned short bf16;
typedef short bf16x8 __attribute__((ext_vector_type(8)));
typedef short s16x4 __attribute__((ext_vector_type(4)));
typedef float f32x16 __attribute__((ext_vector_type(16)));
typedef float f32x4 __attribute__((ext_vector_type(4)));
typedef unsigned u32x4 __attribute__((ext_vector_type(4)));
#define ATT_LAS __attribute__((address_space(3)))
#define ATT_GAS __attribute__((address_space(1)))
constexpr float SCALE = 0.08838834764831845f;
constexpr float THR = 8.f;
constexpr int NW = 8, QBLK = 32, KVBLK = 64, QB = NW * QBLK, DH = 128;
constexpr int SHM_V = KVBLK * DH * 2, SHM_K = KVBLK * DH * 2;
constexpr int RS = 2048, ROS = 512, SEQ = 2048;
constexpr int OFF_WS = 2 * SHM_V + 2 * SHM_K, OFF_CB = OFF_WS + NW * 64 * 4, OFF_SC = OFF_CB + SEQ * 4, ATT_LDS = OFF_SC + 64;

#define KSWZ(row, colB) ((row) * 256 + ((colB) ^ (((row) & 7) << 4)))
#define SBAR() __builtin_amdgcn_sched_barrier(0)
__device__ __forceinline__ int v_st(int k, int c) { const int kk = (k & ~0xC) | ((k & 4) << 1) | ((k & 8) >> 1); return ((kk >> 3) * 4 + (c >> 5)) * 512 + ((kk & 7) * 32 + (c & 31)) * 2; }
__device__ __forceinline__ int v_rd_base(int lane) { return ((lane & 3) << 3) | (((lane >> 2) & 3) << 6) | (((lane >> 4) & 1) << 5) | (((lane >> 5) & 1) << 8); }
constexpr int v_rd_off(int d0, int ks, int half) { return d0 * 512 + ks * 4096 + half * 2048; }
__device__ __forceinline__ int crow(int r, int hi) { return (r & 3) + 8 * (r >> 2) + 4 * hi; }
__device__ __forceinline__ unsigned cvtpk(float lo, float hi) { return pg8::cvt_pk_bf16(lo, hi); }
__device__ __forceinline__ bf16x8 load8(const ATT_GAS bf16* p) { return *(const ATT_GAS bf16x8*)p; }
__device__ __forceinline__ int tok(int v, int dlog) { const int L = SEQ >> dlog; return ((v & (L - 1)) << dlog) | (v >> (11 - dlog)); }

__device__ __forceinline__ void mask_tile(f32x16& p0, f32x16& p1, int dq, unsigned W) {
    const float NEG = -__builtin_inff();
#pragma unroll
    for (int r = 0; r < 16; ++r) {
        const int c = (r & 3) + 8 * (r >> 2);
        if ((unsigned)(dq - c) >= W) p0[r] = NEG;
        if ((unsigned)(dq - c - 32) >= W) p1[r] = NEG;
    }
}
__device__ __forceinline__ void partialSM(f32x16& p0, f32x16& p1, float& m_reg, float& mn, float& alpha) {
    float pmax = p0[0]; for (int r = 1; r < 16; ++r) pmax = fmaxf(pmax, p0[r]); for (int r = 0; r < 16; ++r) pmax = fmaxf(pmax, p1[r]);
    { auto rr = __builtin_amdgcn_permlane32_swap(__float_as_uint(pmax), __float_as_uint(pmax), false, false);
      pmax = fmaxf(__uint_as_float(rr[0]), __uint_as_float(rr[1])); }
    constexpr float C2 = 1.4426950408889634f * SCALE;
    if (__builtin_expect(__all((pmax - m_reg) * SCALE <= THR), 1)) { mn = m_reg; alpha = 1.f; }
    else { mn = fmaxf(m_reg, pmax); alpha = __builtin_amdgcn_exp2f((m_reg - mn) * C2); m_reg = mn; }
    const float mnL = -mn * C2;
    for (int r = 0; r < 16; ++r) p0[r] = fmaf(p0[r], C2, mnL); for (int r = 0; r < 16; ++r) p1[r] = fmaf(p1[r], C2, mnL);
    for (int r = 0; r < 16; ++r) p0[r] = __builtin_amdgcn_exp2f(p0[r]);
}
__device__ __forceinline__ void finishSM(f32x16& p0, f32x16& p1, float alpha, float& l_reg, bf16x8& pa0, bf16x8& pa1, bf16x8& pa2, bf16x8& pa3) {
    for (int r = 0; r < 16; ++r) p1[r] = __builtin_amdgcn_exp2f(p1[r]);
    float ps = 0; for (int r = 0; r < 16; ++r) ps += p0[r]; for (int r = 0; r < 16; ++r) ps += p1[r];
    { auto rr = __builtin_amdgcn_permlane32_swap(__float_as_uint(ps), __float_as_uint(ps), false, false);
      ps = __uint_as_float(rr[0]) + __uint_as_float(rr[1]); }
    l_reg = l_reg * alpha + ps;
#define PK4(P, B_, OUT) do { unsigned a0 = cvtpk(P[B_+0], P[B_+1]), a1 = cvtpk(P[B_+2], P[B_+3]);                          \
        unsigned b0 = cvtpk(P[B_+4], P[B_+5]), b1 = cvtpk(P[B_+6], P[B_+7]);                                             \
        auto r0 = __builtin_amdgcn_permlane32_swap(a0, b0, false, false); auto r1 = __builtin_amdgcn_permlane32_swap(a1, b1, false, false); \
        u32x4 w = {r0[0], r1[0], r0[1], r1[1]}; OUT = *reinterpret_cast<bf16x8*>(&w); } while (0)
    PK4(p0, 0, pa0); PK4(p0, 8, pa1); PK4(p1, 0, pa2); PK4(p1, 8, pa3);
#undef PK4
}
template <int KB, bool SK, bool BIAS>
__device__ __forceinline__ void qkt(f32x16& p0, f32x16& p1, const ATT_LAS char* K_lds, int r32, int hi, const bf16x8* qr, bool act, const ATT_LAS float* cbt) {
    if (SK && !act) { const float NEG = -__builtin_inff();
#pragma unroll
        for (int r = 0; r < 16; ++r) { p0[r] = NEG; p1[r] = NEG; } return; }
    if (BIAS) {
#pragma unroll
        for (int g = 0; g < 4; ++g) { const f32x4 a = *(const ATT_LAS f32x4*)(cbt + 8 * g + 4 * hi), b = *(const ATT_LAS f32x4*)(cbt + 32 + 8 * g + 4 * hi);
            p0[4 * g] = a[0]; p0[4 * g + 1] = a[1]; p0[4 * g + 2] = a[2]; p0[4 * g + 3] = a[3]; p1[4 * g] = b[0]; p1[4 * g + 1] = b[1]; p1[4 * g + 2] = b[2]; p1[4 * g + 3] = b[3]; }
    } else { p0 = f32x16{}; p1 = f32x16{}; }
    const ATT_LAS char* kb[4];
#pragma unroll
    for (int dd = 0; dd < 4; ++dd) kb[dd] = K_lds + KB * SHM_K + KSWZ(r32, (dd * 16 + hi * 8) * 2);
#pragma unroll
    for (int d0 = 0; d0 < 8; ++d0) { const ATT_LAS char* a = kb[d0 & 3] + (d0 >> 2) * 128;
        bf16x8 b0 = *(const ATT_LAS bf16x8*)a;
        bf16x8 b1 = *(const ATT_LAS bf16x8*)(a + 32 * 256);
        p0 = __builtin_amdgcn_mfma_f32_32x32x16_bf16(b0, qr[d0], p0, 0, 0, 0);
        p1 = __builtin_amdgcn_mfma_f32_32x32x16_bf16(b1, qr[d0], p1, 0, 0, 0); }
}
template <int VB, bool SK>
__device__ __forceinline__ void pv_tile(f32x16* o, int vb0, bf16x8 pa0, bf16x8 pa1, bf16x8 pa2, bf16x8 pa3, bool act) {
    if (SK && !act) return;
#define TRRD(dst, off) asm volatile("ds_read_b64_tr_b16 %0, %1 offset:%2" : "=&v"(dst) : "v"(vb0), "i"(off) : "memory")
#define PV_D0(d0) do { s16x4 l0, l1, l2, l3, h0, h1, h2, h3; constexpr int b_ = VB * SHM_V + v_rd_off(d0, 0, 0); \
        TRRD(l0, b_); TRRD(h0, b_ + 2048); TRRD(l1, b_ + 4096); TRRD(h1, b_ + 6144); TRRD(l2, b_ + 8192); TRRD(h2, b_ + 10240); TRRD(l3, b_ + 12288); TRRD(h3, b_ + 14336); \
        asm volatile("s_waitcnt lgkmcnt(0)" ::: "memory"); SBAR();   \
        o[d0] = __builtin_amdgcn_mfma_f32_32x32x16_bf16(pa0, (bf16x8){l0[0], l0[1], l0[2], l0[3], h0[0], h0[1], h0[2], h0[3]}, o[d0], 0, 0, 0);   \
        o[d0] = __builtin_amdgcn_mfma_f32_32x32x16_bf16(pa1, (bf16x8){l1[0], l1[1], l1[2], l1[3], h1[0], h1[1], h1[2], h1[3]}, o[d0], 0, 0, 0);   \
        o[d0] = __builtin_amdgcn_mfma_f32_32x32x16_bf16(pa2, (bf16x8){l2[0], l2[1], l2[2], l2[3], h2[0], h2[1], h2[2], h2[3]}, o[d0], 0, 0, 0);   \
        o[d0] = __builtin_amdgcn_mfma_f32_32x32x16_bf16(pa3, (bf16x8){l3[0], l3[1], l3[2], l3[3], h3[0], h3[1], h3[2], h3[3]}, o[d0], 0, 0, 0); } while (0)
    PV_D0(0); PV_D0(1); PV_D0(2); PV_D0(3);
#undef PV_D0
#undef TRRD
}

struct Bases { const ATT_GAS bf16* Q; const ATT_GAS bf16* K; const ATT_GAS bf16* V; };
struct Ref { int bo; int P0; int dlog; int du; };
struct Seam { bf16x8 qr[8]; bf16x8 st_v0, st_v1, st_k0, st_k1; };
template <bool FOX> __device__ __forceinline__ int blk_jlo(const Ref& r) {
    if (FOX) return 0;
    const int L = SEQ >> r.dlog; int lowk = r.P0 - 128; const int cs = r.P0 & ~(L - 1); if (lowk < cs) lowk = cs; return lowk / KVBLK;
}
#define AROW(p, v, dl) ((p) + (size_t)tok((v), (dl)) * RS + sc)
#define VMW() asm volatile("s_waitcnt vmcnt(0)" ::: "memory")
#define VMWN(n) asm volatile("s_waitcnt vmcnt(%0)" :: "i"(n) : "memory")
#define SLOAD_H(Kp, Vp, k0, dl) do { S.st_v0 = load8(AROW(Vp, (k0) + sr, dl)); S.st_v1 = load8(AROW(Vp, (k0) + 32 + sr, dl));              \
                         S.st_k0 = load8(AROW(Kp, (k0) + sr, dl)); S.st_k1 = load8(AROW(Kp, (k0) + 32 + sr, dl)); } while (0)
#define SWRITE_HK(bf) do { *(ATT_LAS bf16x8*)(K_lds + (bf) * SHM_K + kws) = S.st_k0; *(ATT_LAS bf16x8*)(K_lds + (bf) * SHM_K + kws + 32 * 256) = S.st_k1; } while (0)
#define SWRITE_HV(bf) do { *(ATT_LAS bf16x8*)(V_lds + (bf) * SHM_V + vst0) = S.st_v0; *(ATT_LAS bf16x8*)(V_lds + (bf) * SHM_V + vst1) = S.st_v1; } while (0)
#define SWRITE_H(bf) do { SWRITE_HV(bf); SWRITE_HK(bf); } while (0)
template <bool FOX>
__device__ __forceinline__ void blk_prime(const Bases& AB, const Ref& cur, ATT_LAS char* lds, Seam& S, const int wv) {
    const int lane_ = pg8::mk_lane();
    const int tid = wv * 64 + lane_, wid = wv, lane = lane_, r32 = lane & 31, hi = lane >> 5;
    const int sr = tid >> 4, sc = (tid & 15) * 8, kws = KSWZ(sr, sc * 2); ATT_LAS char* K_lds = lds + 2 * SHM_V;
    const int kb0 = blk_jlo<FOX>(cur) * KVBLK;
    { const ATT_GAS bf16* qp = AB.Q + cur.bo + (size_t)tok(cur.P0 + wid * QBLK + r32, cur.dlog) * RS + hi * 8;
#pragma unroll
      for (int d0 = 0; d0 < 8; ++d0) S.qr[d0] = load8(qp + d0 * 16); }
    SLOAD_H(AB.K + cur.bo, AB.V + cur.bo, kb0, cur.dlog); VMW(); SWRITE_HK(0);
    __syncthreads();
}
template <bool FOX>
__device__ __forceinline__ void blk_run(const Bases& AB, const Ref& cur, const Ref& nxt, ATT_GAS bf16* Oo, const int ros  , ATT_GAS float* LSEo, ATT_LAS char* lds, Seam& S, const int wv) {
    constexpr bool SK = !FOX, BIAS = FOX;
    const int lane_ = pg8::mk_lane();
    const int tid = wv * 64 + lane_, wid = wv, lane = lane_, r32 = lane & 31, hi = lane >> 5;
    const int j_lo = blk_jlo<FOX>(cur);
    const int j_hi = (cur.P0 + QB - 1) / KVBLK + 1;
    const int NT = j_hi - j_lo;
    const int kbn = blk_jlo<FOX>(nxt) * KVBLK;
    const int qlo = cur.P0 + wid * QBLK, qm = qlo + r32 - 4 * hi;
    const int Lm1 = (SEQ >> cur.dlog) - 1;
    int lowq = qlo - 128; { const int cs = qlo & ~Lm1; if (lowq < cs) lowq = cs; }
    unsigned Wl = 0x7fffffffu; if (!FOX) { const unsigned w1 = (unsigned)((qlo + r32) & Lm1) + 1u; Wl = w1 < 129u ? w1 : 129u; }
    ATT_LAS char* V_lds = lds; ATT_LAS char* K_lds = lds + 2 * SHM_V;
    ATT_LAS float* ws = (ATT_LAS float*)(lds + OFF_WS) + wid * 64; ATT_LAS float* li_l = ws; ATT_LAS float* al_l = ws + 32;
    const ATT_LAS float* cb = (const ATT_LAS float*)(lds + OFF_CB);
    float m_reg = -1e30f, l_reg = 0; f32x16 o[4] = {};
    const int sr = tid >> 4, sc = (tid & 15) * 8, vst0 = v_st(sr, sc), vst1 = v_st(32 + sr, sc), kws = KSWZ(sr, sc * 2);
    const int vb0 = (int)(uintptr_t)V_lds + v_rd_base(lane);
    const ATT_GAS bf16* Kh = AB.K + cur.bo; const ATT_GAS bf16* Vh = AB.V + cur.bo; const int dl = cur.dlog;
#define RESC(a) do { if (__any((a) < 1.f)) { if (hi == 0) al_l[r32] = (a); asm volatile("s_waitcnt lgkmcnt(0)" ::: "memory");              \
                     for (int d_ = 0; d_ < 4; ++d_) for (int r = 0; r < 16; ++r) o[d_][r] *= al_l[crow(r, hi)]; } } while (0)
#define KBASE(t) ((j_lo + (t)) * KVBLK)
#define ACT(t) (FOX || (KBASE(t) <= qlo + QBLK - 1 && KBASE(t) + KVBLK - 1 >= lowq))
#define MASKT(P0_, P1_, t) do { const int kb_ = KBASE(t); if (FOX) { if (kb_ + KVBLK - 1 > qlo) mask_tile(P0_, P1_, qm - kb_, Wl); } else { if (ACT(t)) mask_tile(P0_, P1_, qm - kb_, Wl); } } while (0)
#define CBT(t) (cb + KBASE(t))
    constexpr int NQL = 8;
#define SEAM_K0() do { VMWN(NQL); SWRITE_HK(0); SBAR(); } while (0)
    f32x16 pA0, pA1, pB0, pB1; float mnA, mnB, alA, alB; bf16x8 pa0, pa1, pa2, pa3;
    SWRITE_HV(0); SBAR();
    if (NT > 1) { SLOAD_H(Kh, Vh, KBASE(1), dl); }
    SBAR(); qkt<0, SK, BIAS>(pA0, pA1, K_lds, r32, hi, S.qr, ACT(0), CBT(0));
    MASKT(pA0, pA1, 0); partialSM(pA0, pA1, m_reg, mnA, alA);
    if (NT > 1) { VMW(); SWRITE_H(1); }
    __syncthreads();
#define HALF_STEP(PX0, PX1, mnX, alX, PY0, PY1, alY, t, KB, VB, SB) do {                                                      \
        SBAR(); qkt<KB, SK, BIAS>(PX0, PX1, K_lds, r32, hi, S.qr, ACT(t), CBT(t));                                             \
        finishSM(PY0, PY1, alY, l_reg, pa0, pa1, pa2, pa3); SBAR();                                                           \
        if ((t) + 1 < NT) { SLOAD_H(Kh, Vh, KBASE((t) + 1), dl); SBAR(); }                                               \
        pv_tile<VB, SK>(o, vb0, pa0, pa1, pa2, pa3, ACT((t) - 1)); MASKT(PX0, PX1, (t)); partialSM(PX0, PX1, m_reg, mnX, alX);                                        \
        __syncthreads();                                                                                                      \
        if ((t) + 1 < NT) { VMW(); SWRITE_H(SB); }                                                                          \
        RESC(alX); __syncthreads(); } while (0)
    for (int t = 1; t + 1 < NT; t += 2) {
        HALF_STEP(pB0, pB1, mnB, alB, pA0, pA1, alA, t, 1, 0, 0);
        HALF_STEP(pA0, pA1, mnA, alA, pB0, pB1, alB, t + 1, 0, 1, 1);
    }
    const bool even = (NT & 1) == 0;
    if (even) { SBAR(); qkt<1, SK, BIAS>(pB0, pB1, K_lds, r32, hi, S.qr, ACT(NT - 1), CBT(NT - 1)); SBAR(); }
    { SLOAD_H(AB.K + nxt.bo, AB.V + nxt.bo, kbn, nxt.dlog); SBAR();
      const ATT_GAS bf16* qp = AB.Q + nxt.bo + (size_t)tok(nxt.P0 + wid * QBLK + r32, nxt.dlog) * RS + hi * 8;
#pragma unroll
      for (int d0 = 0; d0 < 8; ++d0) S.qr[d0] = load8(qp + d0 * 16); }
    SBAR();
    finishSM(pA0, pA1, alA, l_reg, pa0, pa1, pa2, pa3); SBAR();
    pv_tile<0, SK>(o, vb0, pa0, pa1, pa2, pa3, ACT(even ? NT - 2 : NT - 1));
    if (even) { MASKT(pB0, pB1, NT - 1); partialSM(pB0, pB1, m_reg, mnB, alB); __syncthreads(); RESC(alB);
        finishSM(pB0, pB1, alB, l_reg, pa0, pa1, pa2, pa3); SBAR(); pv_tile<1, SK>(o, vb0, pa0, pa1, pa2, pa3, ACT(NT - 1)); }
    SBAR(); SEAM_K0();
    if (hi == 0) li_l[r32] = l_reg; asm volatile("s_waitcnt lgkmcnt(0)" ::: "memory");
    float rli[16];
#pragma unroll
    for (int r = 0; r < 16; ++r) rli[r] = __builtin_amdgcn_rcpf(li_l[crow(r, hi)]);
#pragma unroll
    for (int r = 0; r < 16; ++r) { const int orow = crow(r, hi);
        ATT_GAS bf16* Ow = Oo + (size_t)tok(qlo + orow, dl) * ros + r32;
#pragma unroll
        for (int d0 = 0; d0 < 4; ++d0) { const float v = o[d0][r] * rli[r];
            const float vn = __int_as_float(__builtin_amdgcn_update_dpp(0, __float_as_int(v), 0xB1, 0xf, 0xf, true));
            if ((r32 & 1) == 0) *(ATT_GAS unsigned*)(Ow + d0 * 32) = cvtpk(v, vn); } }
    if (!FOX) { if (hi == 0) LSEo[(size_t)tok(qlo + r32, dl) * 4] = m_reg * SCALE + 0.6931471805599453f * __builtin_amdgcn_logf(l_reg); }
    __syncthreads();
#undef RESC
#undef KBASE
#undef ACT
#undef MASKT
#undef CBT
#undef SEAM_K0
#undef HALF_STEP
}
#undef AROW
#undef VMW
#undef VMWN
#undef SLOAD_H
#undef SWRITE_HK
#undef SWRITE_HV
#undef SWRITE_H

__device__ __forceinline__ void fox_bias(const ATT_GAS float* flog  , int kref, ATT_LAS char* lds, const int wv) {
    const int lane_ = pg8::mk_lane(); const int tid = wv * 64 + lane_, wid = wv, lane = lane_;
    ATT_LAS float* cb = (ATT_LAS float*)(lds + OFF_CB);
    ATT_LAS float* sc = (ATT_LAS float*)(lds + OFF_SC);
    float a[4];
#pragma unroll
    for (int e = 0; e < 4; ++e) { const float x = flog[(size_t)(4 * tid + e) * 4];
        a[e] = x >= 0.f ? -logf(1.0f + expf(-x)) : x - logf(1.0f + expf(x)); }
    a[1] += a[0]; a[2] += a[1]; a[3] += a[2];
    ATT_LAS float* tot = cb;
    float x = a[3]; tot[tid] = x; __syncthreads();
#pragma unroll 1
    for (int off = 1; off < 512; off <<= 1) { const float y = tid >= off ? tot[tid - off] : 0.f; __syncthreads(); x += y; tot[tid] = x; __syncthreads(); }
    const float ex = x - a[3];
    (void)sc; (void)wid; (void)lane;
#pragma unroll
    for (int e = 0; e < 4; ++e) cb[4 * tid + e] = ex + a[e];
    __syncthreads();
    const float cref = cb[kref];
    __syncthreads();
#pragma unroll
    for (int e = 0; e < 4; ++e) cb[4 * tid + e] = (cref - (ex + a[e])) * 11.313708498984761f;
    __syncthreads();
}
}
constexpr int NWAVES = 8;
#ifndef MK_SINGLE
#define MK_SINGLE 1
#endif
constexpr int BATCH = 8, SEQ = 2048, DM = 2048, DEPTH = 4, NHEAD = 16, HD = 128, DFF = 8192, PLE = 256, INC = 6148, NIN = 10240;
constexpr int M = BATCH * SEQ;
constexpr float NORM_EPS = 1e-6f;
constexpr int PH_PER_LAYER = 9, N_PHASES = 2 + DEPTH * PH_PER_LAYER;

constexpr size_t MiB = 1u << 20;
constexpr size_t WS_CTL = 0, CTL_ZERO_BYTES = 64 * 1024;
constexpr size_t WS_CS = 1 * MiB;
constexpr size_t WS_WF = 1 * MiB + 256 * 1024;
constexpr size_t WS_FLOG = 2 * MiB;
constexpr size_t WS_LSE = 3 * MiB;
constexpr size_t WS_SSQ = 4 * MiB;
constexpr size_t WS_H = 8 * MiB;
constexpr size_t WS_HB0 = 136 * MiB;
constexpr size_t WS_Q = 200 * MiB, WS_K = 264 * MiB, WS_V = 328 * MiB, WS_G = 392 * MiB;
constexpr size_t WS_MRG = WS_K, WS_UP = WS_Q;
constexpr size_t WS_PP = 736 * MiB;
constexpr size_t WS_OG = 520 * MiB, WS_YB = 568 * MiB, WS_HB1 = WS_H;
constexpr size_t WS_PB = 600 * MiB;
constexpr size_t WS_W = 608 * MiB, W_LAYER = 125 * MiB;
constexpr size_t WO_IN = 0, WO_BRB = 40 * MiB, WO_BRA = 42 * MiB, WO_O = 44 * MiB, WO_UP = 52 * MiB, WO_DOWN = 84 * MiB, WO_PG = 116 * MiB, WO_PLE = 124 * MiB;
constexpr size_t WS_W2 = WS_PP + 64 * MiB;
constexpr size_t WS_END = WS_W2 + W_LAYER;
constexpr int CW_BAR = 4096;

constexpr int RING_OFF = 0, RING_BYTES = 131072, RSTD_OFF = 131072, MISC_OFF = 135168, LDS_BYTES = 147456;
static_assert(att::ATT_LDS <= RING_BYTES, "attention LDS fits the ring region");

#define GAS __attribute__((address_space(1)))
#define LAS __attribute__((address_space(3)))
typedef unsigned short bf16;
typedef unsigned v4u __attribute__((ext_vector_type(4)));
typedef unsigned v2u __attribute__((ext_vector_type(2)));
typedef float f32x4 __attribute__((ext_vector_type(4)));
typedef GAS unsigned gu32;
#define RLX_AGENT __ATOMIC_RELAXED, __HIP_MEMORY_SCOPE_AGENT
#define LDS_WAIT() asm volatile("s_waitcnt lgkmcnt(0)" ::: "memory")
#define VM_WAIT() asm volatile("s_waitcnt vmcnt(0)" ::: "memory")
__device__ __forceinline__ unsigned f2bf(float f) { unsigned u = __builtin_bit_cast(unsigned, f); return (u + 0x7fffu + ((u >> 16) & 1u)) >> 16; }
__device__ __forceinline__ unsigned pk2(float lo, float hi) { return f2bf(lo) | (f2bf(hi) << 16); }

#define XB_TMO      128
#define XB_XCNT(j)  (256  + 64 * (j))
#define XB_XSUB(j)  (1280 + 64 * (j))
#define XB_XGEN(j)  (2304 + 64 * (j))
#define XB_TOP      3328
#define XB_TOPGEN   3392
#define XCD_BAR_WORDS 3456
#define XB_SPIN_CAP (1u << 18)
__device__ __forceinline__ unsigned xb_ld(unsigned* p)              { return __hip_atomic_load(p, __ATOMIC_RELAXED, __HIP_MEMORY_SCOPE_AGENT); }
__device__ __forceinline__ unsigned xb_add(unsigned* p, unsigned v) { return __hip_atomic_fetch_add(p, v, __ATOMIC_RELAXED, __HIP_MEMORY_SCOPE_AGENT); }
__device__ __forceinline__ unsigned xb_xcc_id() { return (unsigned)__builtin_amdgcn_s_getreg((3 << 11) | 20) & 0xFu; }
#define XB_SPIN(cond, bar) do { unsigned _sp = 0; while (cond) { __builtin_amdgcn_s_sleep(1); \
    if ((++_sp & 255u) == 0u) { if (xb_ld(&(bar)[XB_TMO])) break; if (_sp > XB_SPIN_CAP) { atomicAdd(&(bar)[XB_TMO], 1u); break; } } } } while (0)
struct XcdBarrier { unsigned* bar; unsigned x; volatile LAS unsigned* st; };
__device__ __forceinline__ XcdBarrier xcd_barrier_post(unsigned* bar, volatile LAS unsigned* st) {
    XcdBarrier b; b.bar = bar; b.x = xb_xcc_id(); b.st = st;
    if (threadIdx.x == 0) (void)xb_add(&bar[XB_XCNT(b.x)], 1u);
    return b;
}
__device__ __forceinline__ void xcd_barrier_complete(unsigned* bar, unsigned x, unsigned& nloc, unsigned& nx) {
    const unsigned G = gridDim.x * gridDim.y * gridDim.z;
    unsigned sum, cnt, mine, sp = 0u;
    for (;;) {
        sum = 0u; cnt = 0u; mine = 0u;
#pragma unroll
        for (unsigned j = 0; j < 16; ++j) { const unsigned c = xb_ld(&bar[XB_XCNT(j)]); sum += c; cnt += (c > 0u) ? 1u : 0u; mine = (j == x) ? c : mine; }
        if (sum == G) break;
        __builtin_amdgcn_s_sleep(1);
        if ((++sp & 255u) == 0u) { if (xb_ld(&bar[XB_TMO])) break; if (sp > XB_SPIN_CAP) { atomicAdd(&bar[XB_TMO], 1u); break; } }
    }
    nloc = mine > 0u ? mine : 1u; nx = cnt > 0u ? cnt : 1u;
}
__device__ __forceinline__ void xcd_barrier(const XcdBarrier& b, const bool leader  ) {
    asm volatile("s_waitcnt vmcnt(0)" ::: "memory");
    __syncthreads();
    if (leader) {
        unsigned* bar = b.bar;
        __builtin_amdgcn_s_waitcnt(0);
        unsigned nloc = b.st[0], nx = b.st[1];
        if (nloc == 0u) { xcd_barrier_complete(bar, b.x, nloc, nx); b.st[0] = nloc; b.st[1] = nx; }
        const unsigned old = xb_add(&bar[XB_XSUB(b.x)], 1u);
        const unsigned gen = old / nloc;
        if (old + 1u == (gen + 1u) * nloc) {
            __builtin_amdgcn_fence(__ATOMIC_RELEASE, "agent");
            asm volatile("s_waitcnt vmcnt(0)" ::: "memory");
            const unsigned og = xb_add(&bar[XB_TOP], 1u);
            const unsigned tg = og / nx;
            if (og + 1u == (tg + 1u) * nx) xb_add(&bar[XB_TOPGEN], 1u);
            else XB_SPIN(xb_ld(&bar[XB_TOPGEN]) == tg, bar);
            __builtin_amdgcn_fence(__ATOMIC_ACQUIRE, "agent");
            xb_add(&bar[XB_XGEN(b.x)], 1u);
            asm volatile("s_waitcnt vmcnt(0)" ::: "memory");
        } else {
            XB_SPIN(xb_ld(&bar[XB_XGEN(b.x)]) == gen, bar);
            __builtin_amdgcn_fence(__ATOMIC_ACQUIRE, "agent");
            asm volatile("s_waitcnt vmcnt(0)" ::: "memory");
        }
    }
    __syncthreads();
}

__device__ __forceinline__ int xcd_arrive(const XcdBarrier& b, unsigned& gen_out) {
    unsigned* bar = b.bar;
    __builtin_amdgcn_s_waitcnt(0);
    unsigned nloc = b.st[0], nx = b.st[1];
    if (nloc == 0u) { xcd_barrier_complete(bar, b.x, nloc, nx); b.st[0] = nloc; b.st[1] = nx; }
    const unsigned old = xb_add(&bar[XB_XSUB(b.x)], 1u);
    const unsigned gen = old / nloc; gen_out = gen;
    if (old + 1u == (gen + 1u) * nloc) {
        __builtin_amdgcn_fence(__ATOMIC_RELEASE, "agent");
        asm volatile("s_waitcnt vmcnt(0)" ::: "memory");
        const unsigned og = xb_add(&bar[XB_TOP], 1u);
        const unsigned tg = og / nx;
        if (og + 1u == (tg + 1u) * nx) xb_add(&bar[XB_TOPGEN], 1u);
        else XB_SPIN(xb_ld(&bar[XB_TOPGEN]) == tg, bar);
        __builtin_amdgcn_fence(__ATOMIC_ACQUIRE, "agent");
        xb_add(&bar[XB_XGEN(b.x)], 1u);
        asm volatile("s_waitcnt vmcnt(0)" ::: "memory");
        return 1;
    }
    return 0;
}

__device__ __forceinline__ float wave_sum(float v) { return pg8::xl_wave_sum(v); }
__device__ __forceinline__ void tr_item(const GAS float* W, int ldw, int K  , GAS bf16* WT, int row_off, const GAS float* gain, LAS float* scr, int kb, int nb, int lane, int kofs = 0) {
    const int k0 = 64 * kb, n0 = 64 * nb, c4 = 4 * (lane & 15), kq = lane >> 4;
    f32x4 w[16];
#pragma unroll
    for (int i = 0; i < 16; ++i) w[i] = __builtin_nontemporal_load((const GAS f32x4*)(W + (size_t)(k0 + 4 * i + kq) * ldw + n0 + c4));
#pragma unroll
    for (int i = 0; i < 16; ++i) { const int kk = 4 * i + kq; f32x4 v = w[i];
        if (gain) v = v * gain[k0 + kk];
        LAS float* s = scr + kk * 65 + c4; s[0] = v[0]; s[1] = v[1]; s[2] = v[2]; s[3] = v[3]; }
    LDS_WAIT(); asm volatile("" ::: "memory");
    const int c = lane & 7;
#pragma unroll
    for (int j = 0; j < 8; ++j) { const int n = (lane >> 3) + 8 * j; const LAS float* s = scr + (8 * c) * 65 + n;
        v4u o; o.x = pk2(s[0 * 65], s[1 * 65]); o.y = pk2(s[2 * 65], s[3 * 65]); o.z = pk2(s[4 * 65], s[5 * 65]); o.w = pk2(s[6 * 65], s[7 * 65]);
        __builtin_nontemporal_store(o, (GAS v4u*)(WT + (size_t)(row_off + n0 + n) * K + kofs + k0 + 8 * c)); }
    LDS_WAIT(); asm volatile("" ::: "memory");
}
__device__ __forceinline__ void rope_cs(int pos, int i, float& c, float& s) {
    const double inv = i == 0 ? 1.0 : i == 1 ? 0.44036660267178046 : i == 2 ? 0.19392274474868576 : i == 3 ? 0.08539710028576561 : i == 4 ? 0.03760603093086393 : i == 5 ? 0.016560440080994446 :
                       i == 6 ? 0.007292664737217109 : i == 7 ? 0.003211445994752591 : i == 8 ? 0.001414213562373095 : i == 9 ? 0.000622772421914596 : i == 10 ? 0.0002742481756762073 :
                       i == 11 ? 0.00012076973741146504 : i == 12 ? 5.318295896944988e-05 : i == 13 ? 2.341999896140934e-05 : i == 14 ? 1.031338537721246e-05 : 4.5416704806078695e-06;
    const double ang = (double)pos * inv;
    const double kq = rint(ang * 0.6366197723675814);
    const double r = fma(-kq, 1.5707963267948966, ang) - kq * 6.123233995736766e-17;
    const double r2 = r * r;
    double sp = r * (1.0 + r2 * (-1.0 / 6 + r2 * (1.0 / 120 + r2 * (-1.0 / 5040 + r2 * (1.0 / 362880 + r2 * (-1.0 / 39916800 + r2 * (1.0 / 6227020800.0)))))));
    double cp = 1.0 + r2 * (-0.5 + r2 * (1.0 / 24 + r2 * (-1.0 / 720 + r2 * (1.0 / 40320 + r2 * (-1.0 / 3628800 + r2 * (1.0 / 479001600 + r2 * (-1.0 / 87178291200.0)))))));
    const int q = ((int)kq) & 3;
    double cc = (q & 1) ? sp : cp, ss = (q & 1) ? cp : sp;
    if (q == 1 || q == 2) cc = -cc;
    if (q == 2 || q == 3) ss = -ss;
    c = (float)cc; s = (float)ss;
}


#define FAST_FOX 1
#define FAST_DIL 1


#define PROFARG
struct Args { const float* in[17]; float* out; unsigned char* ws; int ph_lo, ph_hi, flags, pad; };

__global__ void __launch_bounds__(NWAVES * 64, 2) mk_fwd(Args args) {
    extern __shared__ __attribute__((aligned(16))) unsigned char lds[];
    LAS unsigned char* L0 = (LAS unsigned char*)lds;
    volatile LAS unsigned* MISC0 = (volatile LAS unsigned*)(L0 + MISC_OFF);
    const int tid0 = threadIdx.x; const int wv0 = __builtin_amdgcn_readfirstlane(tid0 >> 6);
    const int G = gridDim.x, cb = blockIdx.x;
    unsigned char* ws = args.ws;
    gu32* ctl = (gu32*)(ws + WS_CTL);
    if (tid0 < 32) MISC0[tid0] = 0u;
    __syncthreads();
    if (MK_SINGLE) (void)xcd_barrier_post((unsigned*)ctl + CW_BAR, MISC0 + 8);
    const int lo = args.ph_lo, hi = args.ph_hi;
#ifndef MK_MASK
#define MK_MASK 0xfff
#endif
#define IN(k) (lo <= (k) && (k) < hi)
#define EN(b) ((MK_MASK >> (b)) & 1)
#define SEAM(k) do { if (IN((k) + 1)) { if (MK_SINGLE) { XcdBarrier b_; b_.bar = (unsigned*)(wsx + WS_CTL) + CW_BAR; b_.x = xb_xcc_id(); b_.st = MISC + 8; xcd_barrier(b_, tid == 0); } } } while (0)
    constexpr int I_IN = 32 * 96, I_G = 32 * 64, I_BR = 8 * 32, I_O = 32 * 32, I_UP = 32 * 128, I_DN = 128 * 32, I_PL = 4 * 32;
    constexpr int I_LAYER = I_IN + I_G + 2 * I_BR + I_O + I_UP + I_DN + I_O + I_PL;
#define W_ITEM(it0_, l0_, wb0_) do { int r_ = (it0_); const size_t ll_ = (size_t)(l0_); GAS unsigned char* const wd_ = (wb0_); \
        const GAS float* W_; const GAS float* gn_ = nullptr; GAS bf16* WT_; int ldw_ = DM, K_ = DM, ro_ = 0, kb_, nb_, ko_ = 0; \
        if (r_ < I_IN) { W_ = INP(3) + ll_ * DM * INC; ldw_ = INC; WT_ = (GAS bf16*)(wd_ + WO_IN); gn_ = INP(2) + ll_ * DM; kb_ = r_ / 96; nb_ = r_ % 96; } \
        else if ((r_ -= I_IN) < I_G) { kb_ = r_ / 64; nb_ = r_ % 64; W_ = INP(5) + ll_ * DM * 4096; ldw_ = 4096; WT_ = (GAS bf16*)(wd_ + WO_IN); gn_ = INP(2) + ll_ * DM; \
            ro_ = 6144 + 256 * ((nb_ & 31) >> 1) + 128 * (nb_ >> 5) + 64 * (nb_ & 1) - 64 * nb_; }     \
        else if ((r_ -= I_G) < I_BR) { W_ = INP(8) + ll_ * 512 * DM; K_ = 1024; WT_ = (GAS bf16*)(wd_ + WO_BRB); kb_ = r_ / 32; nb_ = r_ % 32; } \
        else if ((r_ -= I_BR) < I_BR) { W_ = INP(7) + ll_ * 512 * DM; K_ = 1024; WT_ = (GAS bf16*)(wd_ + WO_BRB); kb_ = r_ / 32; nb_ = r_ % 32; ko_ = 512; } \
        else if ((r_ -= I_BR) < I_O) { W_ = INP(9) + ll_ * DM * DM; WT_ = (GAS bf16*)(wd_ + WO_O); kb_ = r_ / 32; nb_ = r_ % 32; } \
        else if ((r_ -= I_O) < I_UP) { W_ = INP(11) + ll_ * DM * DFF; ldw_ = DFF; WT_ = (GAS bf16*)(wd_ + WO_UP); gn_ = INP(10) + ll_ * DM; kb_ = r_ / 128; nb_ = r_ % 128; } \
        else if ((r_ -= I_UP) < I_DN) { W_ = INP(12) + ll_ * DFF * DM; K_ = DFF; WT_ = (GAS bf16*)(wd_ + WO_DOWN); kb_ = r_ / 32; nb_ = r_ % 32; } \
        else if ((r_ -= I_DN) < I_O) { W_ = INP(15) + ll_ * DM * DM; WT_ = (GAS bf16*)(wd_ + WO_PG); gn_ = INP(13) + ll_ * DM; kb_ = r_ / 32; nb_ = r_ % 32; } \
        else { r_ -= I_O; W_ = INP(14) + ll_ * PLE * DM; K_ = PLE; WT_ = (GAS bf16*)(wd_ + WO_PLE); kb_ = r_ / 32; nb_ = r_ % 32; } \
        tr_item(W_, ldw_, K_, WT_, ro_, gn_, (LAS float*)(L + wave * (64 * 65 * 4)), kb_, nb_, lane, ko_); } while (0)
#ifndef FILL_MASK
#define FILL_MASK 0x200
#endif
#define SEAMF(k, lf_, j_) do { if (IN((k) + 1)) { if (MK_SINGLE) { XcdBarrier b_; b_.bar = (unsigned*)(wsx + WS_CTL) + CW_BAR; b_.x = xb_xcc_id(); b_.st = MISC + 8; const int lfv_ = (lf_); \
        if (lfv_ >= DEPTH || ((FILL_MASK >> (j_)) & 1) == 0) xcd_barrier(b_, tid == 0); \
        else { VM_WAIT(); __syncthreads(); \
            unsigned gen_ = 0u, pc_ = 0u; \
            if (tid == 0) MISC[12] = (unsigned)xcd_arrive(b_, gen_); \
            LDS_WAIT(); __syncthreads(); \
            GAS unsigned char* wb_ = wsx + ((lfv_ & 1) ? WS_W2 : WS_W); \
            while (__builtin_amdgcn_readfirstlane((int)MISC[12]) == 0) { \
                if (tid == 0) { bool dn_ = xb_ld(&b_.bar[XB_XGEN(b_.x)]) != gen_; \
                    if (!dn_ && (++pc_ & 255u) == 0u) { if (xb_ld(&b_.bar[XB_TMO])) dn_ = true; else if (pc_ > XB_SPIN_CAP) { atomicAdd(&b_.bar[XB_TMO], 1u); dn_ = true; } } \
                    if (dn_) { __builtin_amdgcn_fence(__ATOMIC_ACQUIRE, "agent"); VM_WAIT(); MISC[12] = 1u; LDS_WAIT(); } } \
                if (__builtin_amdgcn_readfirstlane((int)MISC[12]) != 0) break; \
                const int k_ = __builtin_amdgcn_readfirstlane((int)MISC[16 + wave]), it_ = gw + k_ * NGW;     \
                if (it_ < I_LAYER) { W_ITEM(it_, lfv_, wb_); if (lane == 0) MISC[16 + wave] = (unsigned)(k_ + 1); LDS_WAIT(); } else __builtin_amdgcn_s_sleep(8); \
            } \
            __syncthreads(); } } } } while (0)
#ifndef SHIFT_ITEMS
#define SHIFT_ITEMS 2
#endif
#define W_PART(kb_) do { if (SHIFT_ITEMS > 0 && l + 1 < DEPTH) { GAS unsigned char* wbp_ = wsx + (((l + 1) & 1) ? WS_W2 : WS_W);     \
        _Pragma("unroll 1") for (int k_ = (kb_); k_ < (kb_) + SHIFT_ITEMS; ++k_) { const int it_ = gw + k_ * NGW; if (it_ < I_LAYER) W_ITEM(it_, l + 1, wbp_); } \
        LDS_WAIT(); __syncthreads(); } } while (0)
#define W_EARLY (((cbx >> 2) & 1) != 0)

    if (tid0 < 18) { const unsigned long long pv = tid0 < 17 ? (unsigned long long)args.in[tid0] : (unsigned long long)args.out; MISC0[32 + 2 * tid0] = (unsigned)pv; MISC0[33 + 2 * tid0] = (unsigned)(pv >> 32); }
    __syncthreads();
#define INP(k) ((const GAS float*)(((unsigned long long)(unsigned)__builtin_amdgcn_readfirstlane((int)MISC[33 + 2 * (k)]) << 32) | (unsigned long long)(unsigned)__builtin_amdgcn_readfirstlane((int)MISC[32 + 2 * (k)])))
#define PHASE_BEGIN() int cbx = cb; GAS unsigned char* wsx = (GAS unsigned char*)ws; int wavep = wv0; unsigned lbp = 0u; asm volatile("" : "+s"(cbx), "+s"(wsx), "+s"(wavep), "+s"(lbp)); \
    LAS unsigned char* L = L0 + lbp; volatile LAS unsigned* MISC = (volatile LAS unsigned*)(L + MISC_OFF); const LAS float* rstd_l = (const LAS float*)(L + RSTD_OFF); \
    const int lane = pg8::mk_lane(), wave = wavep, tid = wave * 64 + lane, gw = cbx * NWAVES + wave, NGW = G * NWAVES; (void)gw; (void)NGW; (void)lane; (void)MISC; (void)rstd_l; (void)tid
#define hbuf ((GAS float*)(wsx + WS_H))
#define hb0 ((GAS bf16*)(wsx + WS_HB0))
#define hb1 ((GAS bf16*)(wsx + WS_HB1))
#define qb ((GAS bf16*)(wsx + WS_Q))
#define kbuf ((GAS bf16*)(wsx + WS_K))
#define vbuf ((GAS bf16*)(wsx + WS_V))
#define gates ((GAS bf16*)(wsx + WS_G))
#define mrg ((GAS bf16*)(wsx + WS_MRG))
#define upb ((GAS bf16*)(wsx + WS_UP))
#define ppb ((GAS bf16*)(wsx + WS_PP))
#define og ((GAS bf16*)(wsx + WS_OG))
#define y2 ((GAS bf16*)(wsx + WS_YB))
#define flog ((GAS float*)(wsx + WS_FLOG))
#define lse ((GAS float*)(wsx + WS_LSE))
#define ssq ((GAS float*)(wsx + WS_SSQ))
#define cst ((GAS float*)(wsx + WS_CS))
#define wfb ((GAS float*)(wsx + WS_WF))
#define wl (wsx + ((l & 1) ? WS_W2 : WS_W))

#define RSTD_TABLE(pm_, ssq_) do { const int r_ = tid >> 1; const GAS float* sp_ = (ssq_) + ((size_t)(pm_) * 256 + r_) * 32 + (tid & 1) * 16; \
        const f32x4 a_ = *(const GAS f32x4*)sp_, b_ = *(const GAS f32x4*)(sp_ + 4), c_ = *(const GAS f32x4*)(sp_ + 8), d_ = *(const GAS f32x4*)(sp_ + 12); \
        float s_ = ((a_[0] + a_[1]) + (a_[2] + a_[3])) + ((b_[0] + b_[1]) + (b_[2] + b_[3])) + ((c_[0] + c_[1]) + (c_[2] + c_[3])) + ((d_[0] + d_[1]) + (d_[2] + d_[3])); \
        s_ += pg8::xl_xor1(s_); if ((tid & 1) == 0) ((LAS float*)(L + RSTD_OFF))[r_] = 1.0f / sqrtf(s_ * (1.0f / DM) + NORM_EPS); LDS_WAIT(); __syncthreads(); } while (0)

    if (EN(9) && IN(0)) {
        PHASE_BEGIN();
        const int gt = cbx * (NWAVES * 64) + tid, NGT = G * NWAVES * 64;
        for (int i = gt; i < SEQ * 16; i += NGT) { float c, s; rope_cs(i >> 4, i & 15, c, s);
            ((GAS unsigned*)cst)[i] = (unsigned)__builtin_bit_cast(unsigned short, (_Float16)c) | ((unsigned)__builtin_bit_cast(unsigned short, (_Float16)s) << 16); }
#pragma unroll 2
        for (int m = gw; m < M; m += NGW) {
            const GAS f32x4* xr = (const GAS f32x4*)(INP(0) + (size_t)m * DM); float s = 0.f;
#pragma unroll
            for (int j = 0; j < 4; ++j) { const f32x4 a = xr[128 * j + 2 * lane], b = xr[128 * j + 2 * lane + 1];
                s += (a[0] * a[0] + a[1] * a[1]) + (a[2] * a[2] + a[3] * a[3]) + (b[0] * b[0] + b[1] * b[1]) + (b[2] * b[2] + b[3] * b[3]);
                v4u o; o.x = pk2(a[0], a[1]); o.y = pk2(a[2], a[3]); o.z = pk2(b[0], b[1]); o.w = pk2(b[2], b[3]);
                *(GAS v4u*)(hb1 + (size_t)m * DM + 512 * j + 8 * lane) = o; }
            s = wave_sum(s);
            if (lane < 32) ssq[(size_t)m * 32 + lane] = lane == 0 ? s : 0.f;
        }
        SEAMF(0, 0, 9);
    }

#define CONV_PWF(ll0_) do { const size_t lc_ = (size_t)(ll0_); const GAS float* gm_ = INP(2) + lc_ * DM; const int gt = cbx * (NWAVES * 64) + tid, NGT = G * NWAVES * 64; \
        for (int i = gt; i < 4 * DM; i += NGT) { const int hh = i / DM, k = i % DM; wfb[i] = gm_[k] * INP(3)[(lc_ * DM + k) * INC + 6144 + hh]; } \
        { const GAS float* p = INP(1) + lc_ * M * PLE; GAS bf16* pbf = (GAS bf16*)(wsx + WS_PB); \
          for (int i = gt; i < M * PLE / 8; i += NGT) { const f32x4 a = *(const GAS f32x4*)(p + (size_t)i * 8), b = *(const GAS f32x4*)(p + (size_t)i * 8 + 4); \
              v4u o; o.x = pk2(a[0], a[1]); o.y = pk2(a[2], a[3]); o.z = pk2(b[0], b[1]); o.w = pk2(b[2], b[3]); *(GAS v4u*)(pbf + (size_t)i * 8) = o; } } } while (0)
    int sbuf = 0;
    for (int l = 0; l < DEPTH; ++l) {
        const int pb = 1 + l * PH_PER_LAYER;
        if (EN(11) && IN(pb + 0) && l == 0) {
            PHASE_BEGIN();
            LDS_WAIT(); __syncthreads();
            { int k_ = __builtin_amdgcn_readfirstlane((int)MISC[16 + wave]);
              for (int it_ = gw + k_ * NGW; it_ < I_LAYER; it_ += NGW) W_ITEM(it_, l, wl);
              if (lane == 0) MISC[16 + wave] = 0u; LDS_WAIT(); }
            CONV_PWF(l);
            SEAMF(pb + 0, l + 1, 0);
        }
        if (EN(0) && IN(pb + 1)) {
            PHASE_BEGIN();
            { const GAS float* wf = wfb; const GAS float* ssc = ssq + (size_t)sbuf * M * 32; const int row0 = cbx * 64 + wave * 8;
              const float bfv = INP(4)[l * 4 + (lane & 3)];
#pragma unroll 1
              for (int g4 = 0; g4 < 8; g4 += 4) {
                  v4u hw[4][4]; float spv[4];
#pragma unroll
                  for (int r = 0; r < 4; ++r) { const int row = row0 + g4 + r;
#pragma unroll
                      for (int j = 0; j < 4; ++j) hw[r][j] = *(const GAS v4u*)(hb1 + (size_t)row * DM + 512 * j + 8 * lane);
                      spv[r] = lane < 32 ? ssc[(size_t)row * 32 + lane] : 0.f; }
#pragma unroll
                  for (int r = 0; r < 4; ++r) { const int row = row0 + g4 + r; float d0 = 0.f, d1 = 0.f, d2 = 0.f, d3 = 0.f;
#pragma unroll
                      for (int j = 0; j < 4; ++j) { const int k0 = 512 * j + 8 * lane; const v4u w = hw[r][j];
                          const f32x4 a = {pg8::bf_lo(w.x), pg8::bf_hi(w.x), pg8::bf_lo(w.y), pg8::bf_hi(w.y)}, b = {pg8::bf_lo(w.z), pg8::bf_hi(w.z), pg8::bf_lo(w.w), pg8::bf_hi(w.w)};
                          f32x4 t;
                          t = a * *(const GAS f32x4*)(wf + k0) + b * *(const GAS f32x4*)(wf + k0 + 4); d0 += (t[0] + t[1]) + (t[2] + t[3]);
                          t = a * *(const GAS f32x4*)(wf + DM + k0) + b * *(const GAS f32x4*)(wf + DM + k0 + 4); d1 += (t[0] + t[1]) + (t[2] + t[3]);
                          t = a * *(const GAS f32x4*)(wf + 2 * DM + k0) + b * *(const GAS f32x4*)(wf + 2 * DM + k0 + 4); d2 += (t[0] + t[1]) + (t[2] + t[3]);
                          t = a * *(const GAS f32x4*)(wf + 3 * DM + k0) + b * *(const GAS f32x4*)(wf + 3 * DM + k0 + 4); d3 += (t[0] + t[1]) + (t[2] + t[3]); }
                      d0 = wave_sum(d0); d1 = wave_sum(d1); d2 = wave_sum(d2); d3 = wave_sum(d3);
                      const float sp = wave_sum(spv[r]);
                      const float rs = 1.0f / sqrtf(sp * (1.0f / DM) + NORM_EPS);
                      const float dd = (lane & 3) == 0 ? d0 : (lane & 3) == 1 ? d1 : (lane & 3) == 2 ? d2 : d3;
                      if (lane < 4) flog[(size_t)row * 4 + lane] = dd * rs + bfv; } } }
            pg8::Gemm g{hb1, (const GAS bf16*)(wl + WO_IN), M, NIN, DM, 0 PROFARG}; pg8::StaticOrder S; S.init(M, NIN, G, cbx);
            pg8::Unit u0; S.next(0, u0);
            RSTD_TABLE(u0.pm, ssq + (size_t)sbuf * M * 32);
            pg8::EpiIn E{qb, gates, INP(6) + (size_t)l * 4096, cst, rstd_l};
            pg8::gemm_phase<pg8::EpiIn, pg8::StaticOrder, true, true>(L + RING_OFF, g, S, E, wave);
            { int kpp = PLE; asm volatile("" : "+s"(kpp));
              pg8::Gemm g2{(const GAS bf16*)(wsx + WS_PB), (const GAS bf16*)(wl + WO_PLE), M, DM, kpp, 0 PROFARG}; pg8::StaticOrder S2; S2.init(M, DM, G, cbx);
              pg8::EpiOut<0> E2{ppb, DM, rstd_l};
              pg8::gemm_phase<pg8::EpiOut<0>, pg8::StaticOrder, true, true>(L + RING_OFF, g2, S2, E2, wave); }
            SEAMF(pb + 1, l + 1, 1);
        }
        if (EN(1) && IN(pb + 2)) {
            PHASE_BEGIN();
            {
            LAS char* al = (LAS char*)(L + RING_OFF);
            const int qbF = 7 - (cbx >> 5), col = cbx & 31, bF = col >> 2, hF = col & 3;
            att::Seam Sm; const att::Bases AB{qb, kbuf, vbuf};
            if (FAST_FOX) { att::Ref cur; cur.bo = (bF * SEQ) * DM + (12 + hF) * HD; cur.P0 = qbF * 256; cur.dlog = 0;
              att::fox_bias(flog + (size_t)bF * SEQ * 4 + hF, cur.P0 + 255, al, wave);
              att::blk_prime<true>(AB, cur, al, Sm, wave);
              att::blk_run<true>(AB, cur, cur, y2 + (size_t)bF * SEQ * 1024 + hF * HD, 1024, nullptr, al, Sm, wave); }
            { const int ndil = (0x11233455 >> (4 * qbF)) & 15; int off = 0; for (int q2 = 0; q2 < qbF; ++q2) off += (0x11233455 >> (4 * q2)) & 15;
#define DIL_REF(R, s_) do { const int du_ = (off + (s_)) * 32 + col, bg_ = du_ >> 5; (R).bo = ((bg_ / 3) * SEQ) * DM + ((bg_ % 3) * 4 + ((du_ >> 3) & 3)) * HD; (R).P0 = (du_ & 7) * 256; (R).dlog = 2 * (bg_ % 3); (R).du = du_; } while (0)
              if (FAST_DIL && ndil > 0) { att::Ref cur, nxt; DIL_REF(cur, 0);
                  att::blk_prime<false>(AB, cur, al, Sm, wave);
                  for (int s = 0; s < ndil; ++s) { if (s + 1 < ndil) DIL_REF(nxt, s + 1); else nxt = cur;
                      const int bg = cur.du >> 5, g_ = bg % 3, b_ = bg / 3, j_ = (cur.du >> 3) & 3;
                      att::blk_run<false>(AB, cur, nxt, og + (size_t)g_ * M * 512 + (size_t)b_ * SEQ * 512 + j_ * HD, 512, lse + (size_t)g_ * M * 4 + (size_t)b_ * SEQ * 4 + j_, al, Sm, wave); cur = nxt; } }
#undef DIL_REF
            }
            }
            SEAMF(pb + 2, l + 1, 2);
        }
        if (EN(2) && IN(pb + 3)) {
            PHASE_BEGIN();
#pragma unroll
            for (int i = 0; i < 8; ++i) { const size_t row = (size_t)cbx * 64 + wave * 8 + i; const int j = lane >> 4;
                const float l0 = lse[row * 4 + j], l1 = lse[(size_t)M * 4 + row * 4 + j], l2 = lse[(size_t)2 * M * 4 + row * 4 + j];
                const float mx = fmaxf(l0, fmaxf(l1, l2)); const float e0 = __expf(l0 - mx), e1 = __expf(l1 - mx), e2 = __expf(l2 - mx); const float inv = 1.0f / (e0 + e1 + e2);
                const v4u a = *(const GAS v4u*)(og + row * 512 + 8 * lane), b = *(const GAS v4u*)(og + (size_t)M * 512 + row * 512 + 8 * lane), c = *(const GAS v4u*)(og + (size_t)2 * M * 512 + row * 512 + 8 * lane);
                const float w0 = e0 * inv, w1 = e1 * inv, w2 = e2 * inv;
                v4u o;
#define MIX2(F) pk2(w0 * pg8::bf_lo(a.F) + w1 * pg8::bf_lo(b.F) + w2 * pg8::bf_lo(c.F), w0 * pg8::bf_hi(a.F) + w1 * pg8::bf_hi(b.F) + w2 * pg8::bf_hi(c.F))
                o.x = MIX2(x); o.y = MIX2(y); o.z = MIX2(z); o.w = MIX2(w);
#undef MIX2
                *(GAS v4u*)(y2 + row * 1024 + 512 + 8 * lane) = o; }
            if (l + 1 < DEPTH) CONV_PWF(l + 1);
            SEAMF(pb + 3, l + 1, 3);
        }
        if (EN(3) && IN(pb + 4)) {
            PHASE_BEGIN();
            pg8::Gemm g{y2, (const GAS bf16*)(wl + WO_BRB), M, DM, 1024, 0 PROFARG}; pg8::StaticOrder S; S.init(M, DM, G, cbx);
            pg8::EpiMerge E{gates, mrg};
            if (W_EARLY) W_PART(0);
            pg8::gemm_phase<pg8::EpiMerge, pg8::StaticOrder, true, true>(L + RING_OFF, g, S, E, wave);
            if (!W_EARLY) W_PART(0);
            SEAMF(pb + 4, l + 1, 4);
        }
        if (EN(4) && IN(pb + 5)) {
            PHASE_BEGIN();
            { pg8::Gemm g{mrg, (const GAS bf16*)(wl + WO_O), M, DM, DM, 0 PROFARG}; pg8::StaticOrder S; S.init(M, DM, G, cbx);
              pg8::EpiRes<0> E{hb1, hb0, ssq + (size_t)(sbuf ^ 1) * M * 32, nullptr, rstd_l};
              if (W_EARLY) W_PART(2);
              pg8::gemm_phase<pg8::EpiRes<0>, pg8::StaticOrder, true, true>(L + RING_OFF, g, S, E, wave);
              if (!W_EARLY) W_PART(2); }
            SEAMF(pb + 5, l + 1, 5);
        }
        sbuf ^= 1;
        if (EN(6) && IN(pb + 6)) {
            PHASE_BEGIN();
            pg8::Gemm g{hb0, (const GAS bf16*)(wl + WO_UP), M, DFF, DM, 0 PROFARG}; pg8::StaticOrder S; S.init(M, DFF, G, cbx);
            pg8::Unit u0; S.next(0, u0);
            RSTD_TABLE(u0.pm, ssq + (size_t)sbuf * M * 32);
            pg8::EpiOut<1> E{upb, DFF, rstd_l};
            pg8::gemm_phase<pg8::EpiOut<1>, pg8::StaticOrder, true, true>(L + RING_OFF, g, S, E, wave);
            SEAMF(pb + 6, l + 1, 6);
        }
        if (EN(7) && IN(pb + 7)) {
            PHASE_BEGIN();
            pg8::Gemm g{upb, (const GAS bf16*)(wl + WO_DOWN), M, DM, DFF, 1 PROFARG}; pg8::StaticOrder S; S.init(M, DM, G, cbx);
            pg8::EpiRes<0> E{hb0, hb0, ssq + (size_t)(sbuf ^ 1) * M * 32, nullptr, rstd_l};
            if (W_EARLY) W_PART(4);
            pg8::gemm_phase<pg8::EpiRes<0>, pg8::StaticOrder, true, true>(L + RING_OFF, g, S, E, wave);
            if (!W_EARLY) W_PART(4);
            SEAMF(pb + 7, l + 1, 7);
        }
        sbuf ^= 1;
        if (EN(8) && IN(pb + 8)) {
            PHASE_BEGIN();
            pg8::Gemm g{hb0, (const GAS bf16*)(wl + WO_PG), M, DM, DM, 0 PROFARG}; pg8::StaticOrder S; S.init(M, DM, G, cbx);
            if (W_EARLY) W_PART(6);
            pg8::Unit u0; S.next(0, u0);
            RSTD_TABLE(u0.pm, ssq + (size_t)sbuf * M * 32);
            pg8::EpiRes<1> E{hb0, hb1, ssq + (size_t)(sbuf ^ 1) * M * 32, ppb, rstd_l};
            pg8::gemm_phase<pg8::EpiRes<1>, pg8::StaticOrder, true, true>(L + RING_OFF, g, S, E, wave);
            if (!W_EARLY) W_PART(6);
            SEAMF(pb + 8, l + 1, 8);
        }
        sbuf ^= 1;
    }
    if (EN(10) && IN(N_PHASES - 1)) {
        PHASE_BEGIN();
        { const GAS float* gf = INP(16); const GAS float* ssc = ssq + (size_t)sbuf * M * 32;
#pragma unroll 2
        for (int m = gw; m < M; m += NGW) {
            float sp = lane < 32 ? ssc[(size_t)m * 32 + lane] : 0.f; sp = wave_sum(sp);
            const float rs = 1.0f / sqrtf(sp * (1.0f / DM) + NORM_EPS);
            const GAS v4u* hr = (const GAS v4u*)(hb1 + (size_t)m * DM); const GAS f32x4* gr = (const GAS f32x4*)gf; GAS f32x4* orow = (GAS f32x4*)(((GAS float*)INP(17)) + (size_t)m * DM);
#pragma unroll
            for (int j = 0; j < 4; ++j) { const v4u w = hr[64 * j + lane]; const f32x4 a = {pg8::bf_lo(w.x), pg8::bf_hi(w.x), pg8::bf_lo(w.y), pg8::bf_hi(w.y)}, b = {pg8::bf_lo(w.z), pg8::bf_hi(w.z), pg8::bf_lo(w.w), pg8::bf_hi(w.w)};
                orow[128 * j + 2 * lane] = a * rs * gr[128 * j + 2 * lane]; orow[128 * j + 2 * lane + 1] = b * rs * gr[128 * j + 2 * lane + 1]; }
        } }
    }
#undef IN
#undef SEAM
#undef SEAMF
#undef W_PART
#undef CONV_PWF
#undef W_EARLY
#undef W_ITEM
#undef RSTD_TABLE
#undef hbuf
#undef hb0
#undef hb1
#undef qb
#undef kbuf
#undef vbuf
#undef gates
#undef mrg
#undef upb
#undef ppb
#undef og
#undef y2
#undef flog
#undef lse
#undef ssq
#undef cst
#undef wfb
#undef wl
}

__global__ void mk_fail(float* out, int n) { const float q = __builtin_nanf(""); for (int i = blockIdx.x * blockDim.x + threadIdx.x; i < n; i += gridDim.x * blockDim.x) out[i] = q; }

extern "C" void kernel_launch(void* const* d_in, const int* in_sizes, int n_in, void* d_out, int out_size, void* d_ws, size_t ws_size, hipStream_t stream) {
    static int grid = 0;
    if (grid == 0) {
        if (n_in != 17 || in_sizes[0] != M * DM || out_size != M * DM || ws_size < WS_END) { fprintf(stderr, "kernel_launch: unexpected shapes (n_in %d, in0 %d, out %d, ws %zu < %zu)\n", n_in, n_in > 0 ? in_sizes[0] : -1, out_size, ws_size, (size_t)WS_END); grid = -1; return; }
        int dev = 0, cus = 0;
        if (hipGetDevice(&dev) != hipSuccess || hipDeviceGetAttribute(&cus, hipDeviceAttributeMultiprocessorCount, dev) != hipSuccess) { grid = -1; return; }
        if (hipFuncSetAttribute((const void*)mk_fwd, hipFuncAttributeMaxDynamicSharedMemorySize, LDS_BYTES) != hipSuccess) { fprintf(stderr, "kernel_launch: hipFuncSetAttribute failed\n"); grid = -1; return; }
        int per_cu = 0;
        if (hipOccupancyMaxActiveBlocksPerMultiprocessor(&per_cu, (const void*)mk_fwd, NWAVES * 64, LDS_BYTES) != hipSuccess || per_cu < 1) fprintf(stderr, "kernel_launch: occupancy query says %d\n", per_cu);
        (void)hipGetLastError();
        if (cus < 256) { fprintf(stderr, "kernel_launch: needs 256 CUs, device has %d\n", cus); grid = -1; return; }
        grid = 256;
    }
    if (grid < 0) { hipLaunchKernelGGL(mk_fail, dim3(1024), dim3(256), 0, stream, (float*)d_out, out_size); return; }
    (void)hipMemsetAsync((char*)d_ws + WS_CTL, 0, CTL_ZERO_BYTES, stream);
    Args a{};
    for (int i = 0; i < 17; ++i) a.in[i] = (const float*)d_in[i];
    a.out = (float*)d_out; a.ws = (unsigned char*)d_ws;
#if MK_SINGLE
    a.ph_lo = 0; a.ph_hi = N_PHASES;
    hipLaunchKernelGGL(mk_fwd, dim3(grid), dim3(NWAVES * 64), LDS_BYTES, stream, a);
#else
    for (int p = 0; p < N_PHASES; ++p) { a.ph_lo = p; a.ph_hi = p + 1;
        hipLaunchKernelGGL(mk_fwd, dim3(grid), dim3(NWAVES * 64), LDS_BYTES, stream, a);
    }
#endif
}
```
